# Optimizing an MI355X kernel written in HIP

```python
import math
import jax, jax.numpy as jnp
from jax import lax
import numpy as np

D_MODEL = 1024
BATCH = 2
SEQ = 8192
DEPTH = 1

MOBA_HEAD_DIM = 64
MOBA_HEADS = (D_MODEL // 2) // MOBA_HEAD_DIM
MOBA_WIDTH = MOBA_HEADS * MOBA_HEAD_DIM
MOBA_BLOCK = 256
MOBA_TOPK = 3
Q_BLOCK = 128
GLA_HEADS = 4
GLA_VAL_DIM = (D_MODEL // 2) // GLA_HEADS
GLA_KEY_DIM = GLA_VAL_DIM // 2
GLA_VWIDTH = GLA_HEADS * GLA_VAL_DIM
GLA_KWIDTH = GLA_HEADS * GLA_KEY_DIM
GLA_GATE_RANK = 16
GLA_GATE_TAU = 16.0
GLA_CHUNK = 64
MIX_WIDTH = MOBA_WIDTH + GLA_VWIDTH
IN_COLS = 3 * MOBA_WIDTH + 2 * GLA_KWIDTH + 2 * GLA_VWIDTH + GLA_GATE_RANK
D_FF = 256 * ((8 * D_MODEL // 3 + 255) // 256)
CONV_WIDTH = 3
ROPE_THETA = 10000.0
EPS = 1e-6

kernel_name = "hymba_moba_gla_convglu"


def rms_norm(x, g):
    xf = x.astype(jnp.float32)
    y = xf * lax.rsqrt(jnp.mean(xf * xf, axis=-1, keepdims=True) + EPS)
    return (y * g.astype(jnp.float32)).astype(x.dtype)


def rope(t, pos):
    hd = t.shape[-1]
    inv_freq = 1.0 / (ROPE_THETA ** (jnp.arange(0, hd, 2, dtype=jnp.float32) / hd))
    ang = pos.astype(jnp.float32)[:, None] * inv_freq[None, :]
    cos = jnp.cos(ang).astype(t.dtype)
    sin = jnp.sin(ang).astype(t.dtype)
    t1, t2 = t[..., : hd // 2], t[..., hd // 2:]
    return jnp.concatenate([t1 * cos - t2 * sin, t2 * cos + t1 * sin], axis=-1)


def moba_attention(q, k, v):
    B, H, S, hd = q.shape
    nb = -(-S // MOBA_BLOCK)
    n_sel = min(MOBA_TOPK, nb)
    pad = nb * MOBA_BLOCK - S
    padw = ((0, 0), (0, 0), (0, pad), (0, 0))
    kp = jnp.pad(k, padw).reshape(B, H, nb, MOBA_BLOCK, hd)
    vp = jnp.pad(v, padw).reshape(B, H, nb, MOBA_BLOCK, hd)
    k_mean = jnp.mean(kp, axis=3)
    q = q * (hd ** -0.5)
    n_qb = S // Q_BLOCK
    gather = jax.vmap(jax.vmap(lambda blocks, idx: blocks[idx]))
    block_ids = jnp.arange(nb)

    def one_query_block(c):
        q0 = c * Q_BLOCK
        qc = lax.dynamic_slice_in_dim(q, q0, Q_BLOCK, axis=2)
        own = q0 // MOBA_BLOCK
        qpos = q0 + jnp.arange(Q_BLOCK)
        gate = jnp.einsum('bhqd,bhnd->bhqn', qc, k_mean).astype(jnp.float32)
        gate = jnp.where((block_ids < own)[None, None, None, :], gate, -jnp.inf)
        top_s, top_i = lax.top_k(gate, n_sel)
        valid = top_s > -jnp.inf
        kg = gather(kp, top_i)
        vg = gather(vp, top_i)
        s_sel = jnp.einsum('bhqd,bhqnkd->bhqnk', qc, kg).astype(jnp.float32)
        s_sel = jnp.where(valid[..., None], s_sel, -jnp.inf)
        s_sel = s_sel.reshape(B, H, Q_BLOCK, n_sel * MOBA_BLOCK)
        k_own = lax.dynamic_index_in_dim(kp, own, axis=2, keepdims=False)
        v_own = lax.dynamic_index_in_dim(vp, own, axis=2, keepdims=False)
        kpos = own * MOBA_BLOCK + jnp.arange(MOBA_BLOCK)
        s_own = jnp.einsum('bhqd,bhkd->bhqk', qc, k_own).astype(jnp.float32)
        s_own = jnp.where(qpos[:, None] >= kpos[None, :], s_own, -jnp.inf)
        p = jax.nn.softmax(jnp.concatenate([s_sel, s_own], axis=-1), axis=-1).astype(v.dtype)
        p_sel = p[..., : n_sel * MOBA_BLOCK].reshape(B, H, Q_BLOCK, n_sel, MOBA_BLOCK)
        p_own = p[..., n_sel * MOBA_BLOCK:]
        return (jnp.einsum('bhqnk,bhqnkd->bhqd', p_sel, vg)
                + jnp.einsum('bhqk,bhkd->bhqd', p_own, v_own))

    out = lax.map(one_query_block, jnp.arange(n_qb))
    return out.transpose(1, 2, 0, 3, 4).reshape(B, H, S, hd)


def gla_attention(q, k, v, log_a):
    B, H, S, dk = q.shape
    dv = v.shape[-1]
    C = GLA_CHUNK
    nc = S // C
    f32 = jnp.float32

    def to_chunks(t):
        return t.astype(f32).reshape(B, H, nc, C, t.shape[-1]).transpose(2, 0, 1, 3, 4)

    qc = to_chunks(q * (dk ** -0.5))
    kc, vc = to_chunks(k), to_chunks(v)
    G = jnp.cumsum(to_chunks(log_a), axis=3)
    causal = jnp.tril(jnp.ones((C, C), dtype=bool))

    def step(state, inp):
        q_, k_, v_, G_ = inp
        diff = G_[:, :, :, None, :] - G_[:, :, None, :, :]
        decay = jnp.exp(jnp.where(causal[None, None, :, :, None], diff, -jnp.inf))
        A = jnp.einsum('bhtd,bhsd,bhtsd->bhts', q_, k_, decay)
        o = (jnp.einsum('bhts,bhsv->bhtv', A, v_)
             + jnp.einsum('bhtd,bhdv->bhtv', q_ * jnp.exp(G_), state))
        G_last = G_[:, :, -1:, :]
        state = (jnp.exp(G_last)[:, :, 0, :, None] * state
                 + jnp.einsum('bhsd,bhsv->bhdv', k_ * jnp.exp(G_last - G_), v_))
        return state, o

    state0 = jnp.zeros((B, H, dk, dv), f32)
    _, o = lax.scan(step, state0, (qc, kc, vc, G))
    return o.transpose(1, 2, 0, 3, 4).reshape(B, H, S, dv)


def causal_dwconv(h, w, b):
    S = h.shape[1]
    hp = jnp.pad(h, ((0, 0), (CONV_WIDTH - 1, 0), (0, 0)))
    return sum(w[j] * hp[:, j:j + S] for j in range(CONV_WIDTH)) + b


def split_heads(t, n_heads):
    B, S, W = t.shape
    return t.reshape(B, S, n_heads, W // n_heads).transpose(0, 2, 1, 3)


def merge_heads(t):
    B, H, S, d = t.shape
    return t.transpose(0, 2, 1, 3).reshape(B, S, H * d)


def setup_inputs(seed: int = 0) -> dict:
    key = jax.random.key(seed)
    ks = jax.random.split(key, 16)
    f32 = jnp.float32
    D, L = D_MODEL, DEPTH
    nrm = lambda k, shape, fan: jax.random.normal(k, shape, f32) * (fan ** -0.5)
    return {
        "x": jax.random.normal(ks[0], (BATCH, SEQ, D), f32),
        "attn_norm_g": 1.0 + 0.02 * jax.random.normal(ks[1], (L, D), f32),
        "w_in": nrm(ks[2], (L, D, IN_COLS), D),
        "w_gate_up": nrm(ks[3], (L, GLA_GATE_RANK, GLA_KWIDTH), GLA_GATE_RANK),
        "b_gate": 0.1 * jax.random.normal(ks[4], (L, GLA_KWIDTH), f32),
        "gla_norm_g": 1.0 + 0.02 * jax.random.normal(ks[5], (L, GLA_HEADS, GLA_VAL_DIM), f32),
        "w_out": nrm(ks[6], (L, MIX_WIDTH, D), MIX_WIDTH),
        "ffn_norm_g": 1.0 + 0.02 * jax.random.normal(ks[7], (L, D), f32),
        "w_ffn_up": nrm(ks[8], (L, D, 2 * D_FF), D),
        "conv_w": nrm(ks[9], (L, CONV_WIDTH, 2 * D_FF), CONV_WIDTH),
        "conv_b": 0.02 * jax.random.normal(ks[10], (L, 2 * D_FF), f32),
        "w_ffn_down": nrm(ks[11], (L, D_FF, D), D_FF),
        "final_norm_g": 1.0 + 0.02 * jax.random.normal(ks[12], (D,), f32),
    }


def reference(x, attn_norm_g, w_in, w_gate_up, b_gate, gla_norm_g, w_out,
              ffn_norm_g, w_ffn_up, conv_w, conv_b, w_ffn_down, final_norm_g):
    B, S, _ = x.shape
    pos = jnp.arange(S)
    o_mq = 0
    o_mk = o_mq + MOBA_WIDTH
    o_mv = o_mk + MOBA_WIDTH
    o_gq = o_mv + MOBA_WIDTH
    o_gk = o_gq + GLA_KWIDTH
    o_gv = o_gk + GLA_KWIDTH
    o_gr = o_gv + GLA_VWIDTH
    o_gg = o_gr + GLA_VWIDTH
    for l in range(DEPTH):
        xn = rms_norm(x, attn_norm_g[l])
        proj = xn @ w_in[l]
        mq = rope(split_heads(proj[..., o_mq:o_mk], MOBA_HEADS), pos)
        mk = rope(split_heads(proj[..., o_mk:o_mv], MOBA_HEADS), pos)
        mv = split_heads(proj[..., o_mv:o_gq], MOBA_HEADS)
        y_moba = merge_heads(moba_attention(mq, mk, mv))
        gq = split_heads(proj[..., o_gq:o_gk], GLA_HEADS)
        gk = split_heads(proj[..., o_gk:o_gv], GLA_HEADS)
        gv = split_heads(proj[..., o_gv:o_gr], GLA_HEADS)
        gr = proj[..., o_gr:o_gg]
        gate_lr = proj[..., o_gg:]
        log_a = jax.nn.log_sigmoid((gate_lr @ w_gate_up[l] + b_gate[l]).astype(jnp.float32)) / GLA_GATE_TAU
        og = gla_attention(gq, gk, gv, split_heads(log_a, GLA_HEADS))
        og = og * lax.rsqrt(jnp.mean(og * og, axis=-1, keepdims=True) + EPS)
        og = og * gla_norm_g[l].astype(jnp.float32)[None, :, None, :]
        y_gla = merge_heads(og).astype(x.dtype) * jax.nn.silu(gr)
        x = x + jnp.concatenate([y_moba, y_gla], axis=-1) @ w_out[l]
        hn = rms_norm(x, ffn_norm_g[l])
        h = causal_dwconv(hn @ w_ffn_up[l], conv_w[l], conv_b[l])
        h_gate, h_val = h[..., :D_FF], h[..., D_FF:]
        x = x + (jax.nn.silu(h_gate) * h_val) @ w_ffn_down[l]
    return rms_norm(x, final_norm_g)
```

```cpp
#include <hip/hip_runtime.h>
#include <cstdio>
#include <cstdint>

typedef unsigned short bf16_t;
constexpr int NB = 2, SEQ = 8192, DM = 1024, M = NB * SEQ;
constexpr int NIN = 3088, DFF = 2816, NUP = 2 * DFF;
constexpr float EPS = 1e-6f;
constexpr float C2 = 0.18033688011112042f;

__device__ __forceinline__ unsigned f2bf(float f) { unsigned u = __builtin_bit_cast(unsigned, f); return (u + 0x7fffu + ((u >> 16) & 1u)) >> 16; }
__device__ __forceinline__ float bf2f(bf16_t h) { return __builtin_bit_cast(float, (unsigned)h << 16); }

__device__ const double INV_FREQ[32] = {1.0, 0.7498942093324559, 0.5623413251903491, 0.4216965034285822, 0.31622776601683794, 0.23713737056616552, 0.1778279410038923, 0.1333521432163324, 0.1, 0.07498942093324558, 0.05623413251903491, 0.042169650342858224, 0.03162277660168379, 0.023713737056616554, 0.01778279410038923, 0.01333521432163324, 0.01, 0.007498942093324558, 0.005623413251903491, 0.004216965034285823, 0.0031622776601683794, 0.0023713737056616554, 0.0017782794100389228, 0.001333521432163324, 0.001, 0.0007498942093324559, 0.0005623413251903491, 0.00042169650342858224, 0.00031622776601683794, 0.00023713737056616554, 0.00017782794100389227, 0.0001333521432163324};

__device__ __forceinline__ float wave_sum(float v) {
#pragma unroll
    for (int o = 1; o < 64; o <<= 1) v += __shfl_xor(v, o);
    return v;
}

__global__ void rope_table_k(float2* tab) {
    const int idx = blockIdx.x * blockDim.x + threadIdx.x; if (idx >= SEQ * 32) return;
    const int pos = idx >> 5, i = idx & 31;
    const double rev = (double)pos * INV_FREQ[i] * 0.15915494309189535;
    const double fr = rev - __builtin_rint(rev);
    const float f = (float)fr;
    tab[idx] = make_float2(__builtin_amdgcn_cosf(f), __builtin_amdgcn_sinf(f));
}

__global__ __launch_bounds__(256) void rmsnorm_k(const float* x, const float* g, float* out) {
    const int row = blockIdx.x * 4 + (threadIdx.x >> 6), lane = threadIdx.x & 63;
    const float4* xr = (const float4*)(x + (size_t)row * DM) + lane; const float4* gr = (const float4*)g + lane;
    float4 v[4]; float s = 0.f;
#pragma unroll
    for (int j = 0; j < 4; ++j) { v[j] = xr[64 * j]; s += v[j].x * v[j].x + v[j].y * v[j].y + v[j].z * v[j].z + v[j].w * v[j].w; }
    const float rstd = 1.0f / sqrtf(wave_sum(s) * (1.0f / DM) + EPS);
    float4* o = (float4*)(out + (size_t)row * DM) + lane;
#pragma unroll
    for (int j = 0; j < 4; ++j) { const float4 gg = gr[64 * j]; o[64 * j] = make_float4(v[j].x * rstd * gg.x, v[j].y * rstd * gg.y, v[j].z * rstd * gg.z, v[j].w * rstd * gg.w); }
}

template <bool A_BF16>
__global__ __launch_bounds__(256) void gemm_naive(const void* A_, int lda, const float* Bm, int N, int K, float* C, int ldc, const float* R, int ldr) {
    __shared__ float As[16][65]; __shared__ float Bs[16][64];
    const int tx = threadIdx.x & 15, ty = threadIdx.x >> 4;
    const int m0 = blockIdx.y * 64, n0 = blockIdx.x * 64;
    float acc[4][4];
#pragma unroll
    for (int i = 0; i < 4; ++i)
#pragma unroll
        for (int j = 0; j < 4; ++j) acc[i][j] = 0.f;
    for (int k0 = 0; k0 < K; k0 += 16) {
#pragma unroll
        for (int i = 0; i < 4; ++i) { const int idx = threadIdx.x + i * 256, r = idx >> 4, c = idx & 15;
            float a; if (A_BF16) a = bf2f(((const bf16_t*)A_)[(size_t)(m0 + r) * lda + k0 + c]); else a = ((const float*)A_)[(size_t)(m0 + r) * lda + k0 + c];
            As[c][r] = a; }
#pragma unroll
        for (int i = 0; i < 4; ++i) { const int idx = threadIdx.x + i * 256, r = idx >> 6, c = idx & 63;
            Bs[r][c] = (n0 + c < N) ? Bm[(size_t)(k0 + r) * N + n0 + c] : 0.f; }
        __syncthreads();
#pragma unroll
        for (int kk = 0; kk < 16; ++kk) { float a[4], b[4];
#pragma unroll
            for (int i = 0; i < 4; ++i) { a[i] = As[kk][ty * 4 + i]; b[i] = Bs[kk][tx * 4 + i]; }
#pragma unroll
            for (int i = 0; i < 4; ++i)
#pragma unroll
                for (int j = 0; j < 4; ++j) acc[i][j] += a[i] * b[j]; }
        __syncthreads();
    }
#pragma unroll
    for (int i = 0; i < 4; ++i)
#pragma unroll
        for (int j = 0; j < 4; ++j) { const int r = m0 + ty * 4 + i, c = n0 + tx * 4 + j;
            if (c < N) { float v = acc[i][j]; if (R) v += R[(size_t)r * ldr + c]; C[(size_t)r * ldc + c] = v; } }
}

struct IF1 { bf16_t *q, *k, *v, *gq, *gk, *gv, *sr; float *loga, *adec, *kmean; const float2* rope; };

__global__ __launch_bounds__(256) void inproj_epi_k(const float* proj, int row0, IF1 o, const float* w_gate_up, const float* b_gate) {
    const int lr = blockIdx.x, row = row0 + lr, t = row % SEQ, tid = threadIdx.x;
    const float* p = proj + (size_t)lr * NIN;
    { const int h = tid >> 5, i = tid & 31; const float2 cs = o.rope[t * 32 + i];
      { const float t1 = p[64 * h + i], t2 = p[64 * h + i + 32]; const float o1 = t1 * cs.x - t2 * cs.y, o2 = t2 * cs.x + t1 * cs.y;
        o.q[(size_t)row * 512 + 64 * h + 2 * i] = (bf16_t)f2bf(o1 * C2); o.q[(size_t)row * 512 + 64 * h + 2 * i + 1] = (bf16_t)f2bf(o2 * C2); }
      { const float t1 = p[512 + 64 * h + i], t2 = p[512 + 64 * h + i + 32]; const float o1 = t1 * cs.x - t2 * cs.y, o2 = t2 * cs.x + t1 * cs.y;
        o.k[(size_t)row * 512 + 64 * h + 2 * i] = (bf16_t)f2bf(o1); o.k[(size_t)row * 512 + 64 * h + 2 * i + 1] = (bf16_t)f2bf(o2); } }
    for (int c = tid; c < 512; c += 256) {
        o.v[(size_t)row * 512 + c] = (bf16_t)f2bf(p[1024 + c]);
        o.gv[(size_t)row * 512 + c] = (bf16_t)f2bf(p[2048 + c]);
        const float r = p[2560 + c]; o.sr[(size_t)row * 512 + c] = (bf16_t)f2bf(r / (1.0f + expf(-r)));
    }
    { const int c = tid;
      o.gq[(size_t)row * 256 + c] = (bf16_t)f2bf(p[1536 + c] * 0.125f);
      o.gk[(size_t)row * 256 + c] = (bf16_t)f2bf(p[1792 + c]);
      float z = b_gate[c];
#pragma unroll
      for (int j = 0; j < 16; ++j) z += p[3072 + j] * w_gate_up[j * 256 + c];
      const float ls = fminf(z, 0.f) - log1pf(expf(-fabsf(z)));
      const float la = ls * (1.0f / 16.0f);
      o.loga[(size_t)row * 256 + c] = la; o.adec[(size_t)row * 256 + c] = expf(la); }
}

__global__ __launch_bounds__(512) void kmean_k(const bf16_t* k, float* kmean) {
    const int bb = blockIdx.x;
    const int c = threadIdx.x; float s = 0.f;
    for (int r = 0; r < 256; ++r) s += bf2f(k[(size_t)(bb * 256 + r) * 512 + c]);
    kmean[(size_t)bb * 512 + c] = s * (1.0f / 256.0f);
}

__global__ __launch_bounds__(256) void moba_naive_k(IF1 a, bf16_t* ymix) {
    const int gw = blockIdx.x * 4 + (threadIdx.x >> 6), lane = threadIdx.x & 63;
    const int row = gw >> 3, h = gw & 7, b = row / SEQ, t = row % SEQ, own = t >> 8;
    const bf16_t* qp = a.q + (size_t)row * 512 + 64 * h;
    float gate = -INFINITY;
    if (lane < own) { const float* km = a.kmean + ((size_t)(b * 32 + lane) * 8 + h) * 64; float s = 0.f;
        for (int p = 0; p < 64; ++p) s += bf2f(qp[p]) * km[p]; gate = s; }
    int selb[4]; int nsel = 0;
#pragma unroll
    for (int it = 0; it < 3; ++it) {
        float mv = gate; int mi = lane;
#pragma unroll
        for (int o = 1; o < 64; o <<= 1) { const float ov = __shfl_xor(mv, o); const int oi = __shfl_xor(mi, o); if (ov > mv || (ov == mv && oi < mi)) { mv = ov; mi = oi; } }
        if (mv > -INFINITY) { selb[it] = mi; nsel = it + 1; if (lane == mi) gate = -INFINITY; } else selb[it] = -1;
    }
    selb[3] = own;
    float sc[4][4];
    float mx = -INFINITY;
#pragma unroll
    for (int c = 0; c < 4; ++c) {
        const int blk = (c < 3) ? selb[c] : own; const bool valid = (c == 3) || (c < nsel);
#pragma unroll
        for (int u = 0; u < 4; ++u) { float s = -INFINITY;
            if (valid) { const int key = blk * 256 + u * 64 + lane;
                if (c < 3 || key <= t) { const bf16_t* kp = a.k + (size_t)(b * SEQ + key) * 512 + 64 * h; float d = 0.f;
                    for (int p = 0; p < 64; ++p) d += bf2f(qp[p]) * bf2f(kp[p]); s = d; } }
            sc[c][u] = s; mx = fmaxf(mx, s); }
    }
#pragma unroll
    for (int o = 1; o < 64; o <<= 1) mx = fmaxf(mx, __shfl_xor(mx, o));
    float l = 0.f;
#pragma unroll
    for (int c = 0; c < 4; ++c)
#pragma unroll
        for (int u = 0; u < 4; ++u) { const float pv = (sc[c][u] == -INFINITY) ? 0.f : exp2f(sc[c][u] - mx); sc[c][u] = pv; l += pv; }
    l = wave_sum(l);
    float acc = 0.f;
#pragma unroll
    for (int c = 0; c < 4; ++c) {
        const int blk = (c < 3) ? selb[c] : own; const bool valid = (c == 3) || (c < nsel);
        if (valid) {
#pragma unroll
            for (int u = 0; u < 4; ++u) {
                for (int j = 0; j < 64; ++j) { const float pj = __shfl(sc[c][u], j); const int key = blk * 256 + u * 64 + j;
                    acc += pj * bf2f(a.v[(size_t)(b * SEQ + key) * 512 + 64 * h + lane]); } } }
    }
    ymix[(size_t)row * 1024 + 64 * h + lane] = (bf16_t)f2bf(acc / l);
}

__global__ __launch_bounds__(128) void gla_rec_k(IF1 a, float* oraw) {
    const int b = blockIdx.x >> 2, h = blockIdx.x & 3, v = threadIdx.x;
    float S[64];
#pragma unroll
    for (int d = 0; d < 64; ++d) S[d] = 0.f;
    for (int t = 0; t < SEQ; ++t) {
        const size_t row = (size_t)b * SEQ + t;
        const float vv = bf2f(a.gv[row * 512 + 128 * h + v]);
        const float* ad = a.adec + row * 256 + 64 * h; const bf16_t* kp = a.gk + row * 256 + 64 * h; const bf16_t* qp = a.gq + row * 256 + 64 * h;
        float o = 0.f;
#pragma unroll
        for (int d = 0; d < 64; ++d) { S[d] = ad[d] * S[d] + bf2f(kp[d]) * vv; o += bf2f(qp[d]) * S[d]; }
        oraw[row * 512 + 128 * h + v] = o;
    }
}

__global__ __launch_bounds__(256) void gla_norm_k(const float* oraw, const float* g, const bf16_t* sr, bf16_t* ymix) {
    const int row = blockIdx.x, h = threadIdx.x >> 6, lane = threadIdx.x & 63;
    const float o0 = oraw[(size_t)row * 512 + 128 * h + lane], o1 = oraw[(size_t)row * 512 + 128 * h + 64 + lane];
    const float ms = wave_sum(o0 * o0 + o1 * o1) * (1.0f / 128.0f); const float rstd = 1.0f / sqrtf(ms + EPS);
    const float y0 = o0 * rstd * g[128 * h + lane] * bf2f(sr[(size_t)row * 512 + 128 * h + lane]);
    const float y1 = o1 * rstd * g[128 * h + 64 + lane] * bf2f(sr[(size_t)row * 512 + 128 * h + 64 + lane]);
    ymix[(size_t)row * 1024 + 512 + 128 * h + lane] = (bf16_t)f2bf(y0); ymix[(size_t)row * 1024 + 512 + 128 * h + 64 + lane] = (bf16_t)f2bf(y1);
}

__global__ __launch_bounds__(256) void hs_k(const float* h, const float* g, bf16_t* hs, float* ssq) {
    const int row = blockIdx.x * 4 + (threadIdx.x >> 6), lane = threadIdx.x & 63;
#pragma unroll
    for (int j = 0; j < 4; ++j) { const float4 v = ((const float4*)(h + (size_t)row * DM))[64 * j + lane]; const float4 gg = ((const float4*)g)[64 * j + lane];
        const float s = wave_sum(v.x * v.x + v.y * v.y + v.z * v.z + v.w * v.w); if (lane == 0) ssq[(size_t)row * 4 + j] = s;
        bf16_t* o = hs + (size_t)row * DM + (64 * j + lane) * 4;
        o[0] = (bf16_t)f2bf(v.x * gg.x); o[1] = (bf16_t)f2bf(v.y * gg.y); o[2] = (bf16_t)f2bf(v.z * gg.z); o[3] = (bf16_t)f2bf(v.w * gg.w); }
}

__global__ __launch_bounds__(256) void convgate_k(const float* hup, int row0, int halo, const float* ssq, const float* cw, const float* cb, bf16_t* act) {
    const int row = row0 + blockIdx.y, t = row % SEQ; const int ch = blockIdx.x * 256 + threadIdx.x;
    float g = cb[ch], vl = cb[DFF + ch];
#pragma unroll
    for (int j = 0; j < 3; ++j) { const int dt = 2 - j; if (t - dt < 0) continue; const int r = row - dt;
        const float rs = 1.0f / sqrtf((ssq[(size_t)r * 4] + ssq[(size_t)r * 4 + 1] + ssq[(size_t)r * 4 + 2] + ssq[(size_t)r * 4 + 3]) * (1.0f / DM) + EPS);
        const float* hp = hup + (size_t)(r - row0 + halo) * NUP;
        g += cw[j * NUP + ch] * rs * hp[ch]; vl += cw[j * NUP + DFF + ch] * rs * hp[DFF + ch]; }
    act[(size_t)row * DFF + ch] = (bf16_t)f2bf(g / (1.0f + expf(-g)) * vl);
}

extern "C" void kernel_launch(void* const* d_in, const int* in_sizes, int n_in, void* d_out, int out_size, void* d_ws, size_t ws_size, hipStream_t stream) {
    const float* x = (const float*)d_in[0]; const float* g_attn = (const float*)d_in[1]; const float* w_in = (const float*)d_in[2]; const float* w_gate_up = (const float*)d_in[3];
    const float* b_gate = (const float*)d_in[4]; const float* g_gla = (const float*)d_in[5]; const float* w_out = (const float*)d_in[6]; const float* g_ffn = (const float*)d_in[7];
    const float* w_up = (const float*)d_in[8]; const float* conv_w = (const float*)d_in[9]; const float* conv_b = (const float*)d_in[10]; const float* w_down = (const float*)d_in[11];
    const float* g_final = (const float*)d_in[12];
    float* out = (float*)d_out; unsigned char* ws = (unsigned char*)d_ws;
    constexpr size_t MiB = 1u << 20;
    if (ws_size < 256 * MiB) { fprintf(stderr, "ws too small\n"); return; }
    float* proj = (float*)ws; float* oraw = (float*)ws; bf16_t* hs = (bf16_t*)ws;
    bf16_t* ymix = (bf16_t*)(ws + 32 * MiB);
    IF1 f; f.kmean = (float*)(ws + 238 * MiB); f.rope = (const float2*)(ws + 236 * MiB);
    float* ssq = (float*)(ws + 240 * MiB);
    f.q = (bf16_t*)(ws + 100 * MiB); f.k = (bf16_t*)(ws + 116 * MiB); f.v = (bf16_t*)(ws + 132 * MiB); f.gq = (bf16_t*)(ws + 148 * MiB); f.gk = (bf16_t*)(ws + 156 * MiB);
    f.gv = (bf16_t*)(ws + 164 * MiB); f.sr = (bf16_t*)(ws + 180 * MiB); f.loga = (float*)(ws + 196 * MiB); f.adec = (float*)(ws + 212 * MiB);
    bf16_t* act = (bf16_t*)(ws + 100 * MiB); float* hup = (float*)(ws + 190 * MiB);
    float* xn = out;

    rope_table_k<<<SEQ * 32 / 256, 256, 0, stream>>>((float2*)(ws + 236 * MiB));
    rmsnorm_k<<<M / 4, 256, 0, stream>>>(x, g_attn, xn);
    for (int half = 0; half < 2; ++half) {
        gemm_naive<false><<<dim3((NIN + 63) / 64, SEQ / 64), 256, 0, stream>>>(xn + (size_t)half * SEQ * DM, DM, w_in, NIN, DM, proj, NIN, nullptr, 0);
        inproj_epi_k<<<SEQ, 256, 0, stream>>>(proj, half * SEQ, f, w_gate_up, b_gate);
    }
    kmean_k<<<NB * 32, 512, 0, stream>>>(f.k, f.kmean);
    moba_naive_k<<<M * 8 / 4, 256, 0, stream>>>(f, ymix);
    gla_rec_k<<<NB * 4, 128, 0, stream>>>(f, oraw);
    gla_norm_k<<<M, 256, 0, stream>>>(oraw, g_gla, f.sr, ymix);
    gemm_naive<true><<<dim3(DM / 64, M / 64), 256, 0, stream>>>(ymix, 1024, w_out, DM, 1024, out, DM, x, DM);
    hs_k<<<M / 4, 256, 0, stream>>>(out, g_ffn, hs, ssq);
    constexpr int CH = 2048;
    for (int c = 0; c < M / CH; ++c) {
        const int row0 = c * CH; const int halo = (row0 == 0) ? 0 : 2;
        const int nrows = CH + (halo ? 64 : 0);
        const int astart = row0 - (halo ? 64 : 0);
        const int halo_eff = row0 - astart;
        gemm_naive<true><<<dim3(NUP / 64, nrows / 64), 256, 0, stream>>>(hs + (size_t)astart * DM, DM, w_up, NUP, DM, hup, NUP, nullptr, 0);
        convgate_k<<<dim3(DFF / 256, CH), 256, 0, stream>>>(hup, row0, halo_eff, ssq, conv_w, conv_b, act);
    }
    gemm_naive<true><<<dim3(DM / 64, M / 64), 256, 0, stream>>>(act, DFF, w_down, DM, DFF, out, DM, out, DM);
    rmsnorm_k<<<M / 4, 256, 0, stream>>>(out, g_final, out);
}
```

```cpp
#include <hip/hip_runtime.h>
#include <cstdio>
#include <cstdint>

typedef unsigned short bf16_t;
constexpr int NB = 2, SEQ = 8192, DM = 1024, M = NB * SEQ;
constexpr int NIN = 3088, DFF = 2816, NUP = 2 * DFF, NINP = 3328;
constexpr float EPS = 1e-6f;
constexpr float C2 = 0.18033688011112042f;

__device__ __forceinline__ unsigned f2bf(float f) { unsigned u = __builtin_bit_cast(unsigned, f); return (u + 0x7fffu + ((u >> 16) & 1u)) >> 16; }
__device__ __forceinline__ float bf2f(bf16_t h) { return __builtin_bit_cast(float, (unsigned)h << 16); }

__device__ const double INV_FREQ[32] = {1.0, 0.7498942093324559, 0.5623413251903491, 0.4216965034285822, 0.31622776601683794, 0.23713737056616552, 0.1778279410038923, 0.1333521432163324, 0.1, 0.07498942093324558, 0.05623413251903491, 0.042169650342858224, 0.03162277660168379, 0.023713737056616554, 0.01778279410038923, 0.01333521432163324, 0.01, 0.007498942093324558, 0.005623413251903491, 0.004216965034285823, 0.0031622776601683794, 0.0023713737056616554, 0.0017782794100389228, 0.001333521432163324, 0.001, 0.0007498942093324559, 0.0005623413251903491, 0.00042169650342858224, 0.00031622776601683794, 0.00023713737056616554, 0.00017782794100389227, 0.0001333521432163324};

__device__ __forceinline__ float wave_sum(float v) {
#pragma unroll
    for (int o = 1; o < 64; o <<= 1) v += __shfl_xor(v, o);
    return v;
}

struct IF1 { bf16_t *q, *k, *v, *gq, *gk, *gv, *sr; float *loga, *adec, *kmean; const float2* rope; };
__global__ __launch_bounds__(256) void moba_naive_k(IF1 a, bf16_t* ymix) {
    const int gw = blockIdx.x * 4 + (threadIdx.x >> 6), lane = threadIdx.x & 63;
    const int row = gw >> 3, h = gw & 7, b = row / SEQ, t = row % SEQ, own = t >> 8;
    const bf16_t* qp = a.q + (size_t)row * 512 + 64 * h;
    float gate = -INFINITY;
    if (lane < own) { const float* km = a.kmean + ((size_t)(b * 32 + lane) * 8 + h) * 64; float s = 0.f;
        for (int p = 0; p < 64; ++p) s += bf2f(qp[p]) * km[p]; gate = s; }
    int selb[4]; int nsel = 0;
#pragma unroll
    for (int it = 0; it < 3; ++it) {
        float mv = gate; int mi = lane;
#pragma unroll
        for (int o = 1; o < 64; o <<= 1) { const float ov = __shfl_xor(mv, o); const int oi = __shfl_xor(mi, o); if (ov > mv || (ov == mv && oi < mi)) { mv = ov; mi = oi; } }
        if (mv > -INFINITY) { selb[it] = mi; nsel = it + 1; if (lane == mi) gate = -INFINITY; } else selb[it] = -1;
    }
    selb[3] = own;
    float sc[4][4];
    float mx = -INFINITY;
#pragma unroll
    for (int c = 0; c < 4; ++c) {
        const int blk = (c < 3) ? selb[c] : own; const bool valid = (c == 3) || (c < nsel);
#pragma unroll
        for (int u = 0; u < 4; ++u) { float s = -INFINITY;
            if (valid) { const int key = blk * 256 + u * 64 + lane;
                if (c < 3 || key <= t) { const bf16_t* kp = a.k + (size_t)(b * SEQ + key) * 512 + 64 * h; float d = 0.f;
                    for (int p = 0; p < 64; ++p) d += bf2f(qp[p]) * bf2f(kp[p]); s = d; } }
            sc[c][u] = s; mx = fmaxf(mx, s); }
    }
#pragma unroll
    for (int o = 1; o < 64; o <<= 1) mx = fmaxf(mx, __shfl_xor(mx, o));
    float l = 0.f;
#pragma unroll
    for (int c = 0; c < 4; ++c)
#pragma unroll
        for (int u = 0; u < 4; ++u) { const float pv = (sc[c][u] == -INFINITY) ? 0.f : exp2f(sc[c][u] - mx); sc[c][u] = pv; l += pv; }
    l = wave_sum(l);
    float acc = 0.f;
#pragma unroll
    for (int c = 0; c < 4; ++c) {
        const int blk = (c < 3) ? selb[c] : own; const bool valid = (c == 3) || (c < nsel);
        if (valid) {
#pragma unroll
            for (int u = 0; u < 4; ++u) {
                for (int j = 0; j < 64; ++j) { const float pj = __shfl(sc[c][u], j); const int key = blk * 256 + u * 64 + j;
                    acc += pj * bf2f(a.v[(size_t)(b * SEQ + key) * 512 + 64 * h + lane]); } } }
    }
    ymix[(size_t)row * 1024 + 64 * h + lane] = (bf16_t)f2bf(acc / l);
}

__global__ __launch_bounds__(128) void gla_rec_k(IF1 a, float* oraw) {
    const int b = blockIdx.x >> 2, h = blockIdx.x & 3, v = threadIdx.x;
    float S[64];
#pragma unroll
    for (int d = 0; d < 64; ++d) S[d] = 0.f;
    for (int t = 0; t < SEQ; ++t) {
        const size_t row = (size_t)b * SEQ + t;
        const float vv = bf2f(a.gv[row * 512 + 128 * h + v]);
        const float* ad = a.adec + row * 256 + 64 * h; const bf16_t* kp = a.gk + row * 256 + 64 * h; const bf16_t* qp = a.gq + row * 256 + 64 * h;
        float o = 0.f;
#pragma unroll
        for (int d = 0; d < 64; ++d) { S[d] = ad[d] * S[d] + bf2f(kp[d]) * vv; o += bf2f(qp[d]) * S[d]; }
        oraw[row * 512 + 128 * h + v] = o;
    }
}

__global__ __launch_bounds__(256) void gla_norm_k(const float* oraw, const float* g, const bf16_t* sr, bf16_t* ymix) {
    const int row = blockIdx.x, h = threadIdx.x >> 6, lane = threadIdx.x & 63;
    const float o0 = oraw[(size_t)row * 512 + 128 * h + lane], o1 = oraw[(size_t)row * 512 + 128 * h + 64 + lane];
    const float ms = wave_sum(o0 * o0 + o1 * o1) * (1.0f / 128.0f); const float rstd = 1.0f / sqrtf(ms + EPS);
    const float y0 = o0 * rstd * g[128 * h + lane] * bf2f(sr[(size_t)row * 512 + 128 * h + lane]);
    const float y1 = o1 * rstd * g[128 * h + 64 + lane] * bf2f(sr[(size_t)row * 512 + 128 * h + 64 + lane]);
    ymix[(size_t)row * 1024 + 512 + 128 * h + lane] = (bf16_t)f2bf(y0); ymix[(size_t)row * 1024 + 512 + 128 * h + 64 + lane] = (bf16_t)f2bf(y1);
}


namespace pg8 {
#define PG8_LAS __attribute__((address_space(3)))
typedef unsigned short bf16_t;
typedef short bf16x8 __attribute__((ext_vector_type(8)));
typedef float f32x4 __attribute__((ext_vector_type(4)));
typedef unsigned u32x4 __attribute__((ext_vector_type(4)));
constexpr int BM = 256, BK = 64, HALF = 128, HTB = HALF * BK * 2  , STAGE_BYTES = 8 * HTB, NXCD = 8, WGM = 8;

__host__ __device__ __forceinline__ int lds_byte(int r, int c) { const int st = (r >> 4) * 2 + (c >> 5), rr = r & 15, cc = c & 31, ob = rr * 64 + cc * 2; return st * 1024 + (ob ^ (((ob >> 9) & 1) << 5)); }
__host__ __device__ __forceinline__ void stage_rc(int b, int& R, int& C) { const int st = b / 1024, sb = b % 1024, swz = sb ^ (((sb >> 9) & 1) << 5); R = (st >> 1) * 16 + swz / 64; C = (st & 1) * 32 + (swz % 64) / 2; }
__host__ __device__ __forceinline__ int perm32(int rho) { const int n = rho >> 4, i = rho & 15; return 8 * (i >> 2) + 4 * n + (i & 3); }

struct Unit { int pm, pn; };
struct Gemm { const bf16_t* A; const bf16_t* Bt; int M, N, K; };

struct StaticOrder {
    int nM, nN, nwg, G, c;
    __host__ __device__ void init(int nM_, int nN_, int G_, int c_) { nM = nM_; nN = nN_; nwg = nM * nN; G = G_; c = c_; }
    __host__ __device__ bool next(int i, Unit& u) const {
        const long L = (long)i * G + c; if (L >= nwg) return false;
        int wgid = (int)L; { const int q = nwg / NXCD, r = nwg % NXCD, xcd = wgid % NXCD, off = wgid / NXCD; wgid = (xcd < r ? xcd * (q + 1) : r * (q + 1) + (xcd - r) * q) + off; }
        const int nig = WGM * nN, gid = wgid / nig, fm = gid * WGM, gsz = (nM - fm) < WGM ? (nM - fm) : WGM;
        u.pm = fm + ((wgid % nig) % gsz); u.pn = (wgid % nig) / gsz; return true;
    }
    __device__ __forceinline__ void a_ready(const Unit&) const {}
    __device__ __forceinline__ void done(const Unit&) const {}
};

struct AMapStd { static constexpr int HALF_ROWS = 128; static __device__ __forceinline__ int rowmap(int R) { return R; } static __device__ __forceinline__ int tile_row(int pm) { return pm * 256; } };
struct AMapConv { static constexpr int HALF_ROWS = 64; static __device__ __forceinline__ int rowmap(int R) { return 126 * (R >> 6) + (R & 63); }
    static __device__ __forceinline__ int tile_row(int pm) { return (pm / 33) * SEQ + 252 * (pm % 33) - 2; } };

__device__ __forceinline__ unsigned cvt_pk_bf16(float lo, float hi) { unsigned r; asm volatile("v_cvt_pk_bf16_f32 %0, %1, %2" : "=v"(r) : "v"(lo), "v"(hi)); return r; }
__device__ __forceinline__ u32x4 pack8(const f32x4 a, const f32x4 b) { u32x4 w; w.x = cvt_pk_bf16(a[0], a[1]); w.y = cvt_pk_bf16(a[2], a[3]); w.z = cvt_pk_bf16(b[0], b[1]); w.w = cvt_pk_bf16(b[2], b[3]); return w; }
__device__ __forceinline__ float silu_f(float r) { return r * __builtin_amdgcn_rcpf(1.0f + __expf(-r)); }

struct EpiInProj {
    static constexpr bool PERM = true, AFTER_DRAIN = false;
    bf16_t *q, *k, *v, *gq, *gk, *gv, *sr; float *loga, *kmean; const float* rope; const float* b_gate;
    template <bool ISQ> __device__ __forceinline__ void rope_tile(const f32x4 (&acc)[2][2][4][2], const Unit& u, int row0, int cw, int fr) const {
        bf16_t* dst = ISQ ? q : k; const int colt = (u.pn & 1) * 256; const float sc = ISQ ? C2 : 1.0f;
        float ks[2][8];
#pragma unroll
        for (int bj = 0; bj < 2; ++bj)
#pragma unroll
            for (int e = 0; e < 8; ++e) ks[bj][e] = 0.f;
#pragma unroll
        for (int ai = 0; ai < 2; ++ai)
#pragma unroll
            for (int m = 0; m < 4; ++m) { const int row = row0 + ai * HALF + m * 16; const int t = row & (SEQ - 1);
#pragma unroll
                for (int bj = 0; bj < 2; ++bj) { const int col = colt + bj * HALF + cw; const int i0 = (col & 63) >> 1;
                    const float* rp = rope + (size_t)(t * 32 + i0) * 2; const f32x4 c0 = *(const f32x4*)rp, c1 = *(const f32x4*)(rp + 4);
                    const f32x4 a = acc[ai][bj][m][0], b = acc[ai][bj][m][1]; float o[8];
                    o[0] = a[0] * c0[0] - a[1] * c0[1]; o[1] = a[1] * c0[0] + a[0] * c0[1];
                    o[2] = a[2] * c0[2] - a[3] * c0[3]; o[3] = a[3] * c0[2] + a[2] * c0[3];
                    o[4] = b[0] * c1[0] - b[1] * c1[1]; o[5] = b[1] * c1[0] + b[0] * c1[1];
                    o[6] = b[2] * c1[2] - b[3] * c1[3]; o[7] = b[3] * c1[2] + b[2] * c1[3];
                    if (!ISQ) {
#pragma unroll
                        for (int e = 0; e < 8; ++e) ks[bj][e] += o[e]; }
                    u32x4 w; w.x = cvt_pk_bf16(o[0] * sc, o[1] * sc); w.y = cvt_pk_bf16(o[2] * sc, o[3] * sc); w.z = cvt_pk_bf16(o[4] * sc, o[5] * sc); w.w = cvt_pk_bf16(o[6] * sc, o[7] * sc);
                    *(u32x4*)(dst + (size_t)row * 512 + col) = w; }
                if (!ISQ) {
#pragma unroll
                    for (int bj = 0; bj < 2; ++bj)
#pragma unroll
                        for (int e = 0; e < 8; ++e) asm volatile("" : "+v"(ks[bj][e])); }
                asm volatile("" ::: "memory"); __builtin_amdgcn_sched_barrier(0); }
        if (!ISQ) {
#pragma unroll
            for (int bj = 0; bj < 2; ++bj)
#pragma unroll
                for (int e = 0; e < 8; ++e) { float s = ks[bj][e]; s += __shfl_xor(s, 1); s += __shfl_xor(s, 2); s += __shfl_xor(s, 4); s += __shfl_xor(s, 8);
                    if (fr == 0) __hip_atomic_fetch_add(kmean + (size_t)u.pm * 512 + colt + bj * HALF + cw + e, s * (1.0f / 256.0f), __ATOMIC_RELAXED, __HIP_MEMORY_SCOPE_AGENT); }
        }
    }
    __device__ __forceinline__ void operator()(const f32x4 (&acc)[2][2][4][2], const Unit& u, int wr, int wc, int fr, int fq) const {
        const int pn = u.pn; const int row0 = u.pm * BM + wr * 64 + fr; const int cw = wc * 32 + 8 * fq;
        if (pn < 2) { rope_tile<true>(acc, u, row0, cw, fr); return; }
        if (pn < 4) { rope_tile<false>(acc, u, row0, cw, fr); return; }
        if (pn == 12) {
            f32x4 bv[2][2];
#pragma unroll
            for (int bj = 0; bj < 2; ++bj)
#pragma unroll
                for (int n = 0; n < 2; ++n) bv[bj][n] = *(const f32x4*)(b_gate + bj * HALF + cw + 4 * n);
#pragma unroll
            for (int ai = 0; ai < 2; ++ai)
#pragma unroll
                for (int m = 0; m < 4; ++m) { const int row = row0 + ai * HALF + m * 16;
#pragma unroll
                    for (int bj = 0; bj < 2; ++bj)
#pragma unroll
                        for (int n = 0; n < 2; ++n) { const f32x4 z = acc[ai][bj][m][n] + bv[bj][n]; f32x4 la;
#pragma unroll
                            for (int e = 0; e < 4; ++e) la[e] = (fminf(z[e], 0.f) - __logf(1.0f + __expf(-fabsf(z[e])))) * (1.0f / 16.0f);
                            *(f32x4*)(loga + (size_t)row * 256 + bj * HALF + cw + 4 * n) = la; } }
            return;
        }
        bf16_t* dst; int ld, colt, mode;
        if (pn < 6) { dst = v; ld = 512; colt = (pn - 4) * 256; mode = 0; }
        else if (pn == 6) { dst = gq; ld = 256; colt = 0; mode = 1; }
        else if (pn == 7) { dst = gk; ld = 256; colt = 0; mode = 0; }
        else if (pn < 10) { dst = gv; ld = 512; colt = (pn - 8) * 256; mode = 0; }
        else { dst = sr; ld = 512; colt = (pn - 10) * 256; mode = 2; }
        const float sc = (mode == 1) ? 0.125f : 1.0f;
#pragma unroll
        for (int ai = 0; ai < 2; ++ai)
#pragma unroll
            for (int m = 0; m < 4; ++m) { bf16_t* rowp = dst + (size_t)(row0 + ai * HALF + m * 16) * ld + colt + cw;
#pragma unroll
                for (int bj = 0; bj < 2; ++bj) { f32x4 a = acc[ai][bj][m][0], b = acc[ai][bj][m][1];
                    if (mode == 2) {
#pragma unroll
                        for (int e = 0; e < 4; ++e) { a[e] = silu_f(a[e]); b[e] = silu_f(b[e]); } }
                    else { a = a * sc; b = b * sc; }
                    *(u32x4*)(rowp + bj * HALF) = pack8(a, b); } }
    }
};

struct EpiOutProj {
    static constexpr bool PERM = true, AFTER_DRAIN = false;
    const float* x; float* h; bf16_t* hs; const float* g; float* ssq;
    __device__ __forceinline__ void operator()(const f32x4 (&acc)[2][2][4][2], const Unit& u, int wr, int wc, int fr, int fq) const {
        const int row0 = u.pm * BM + wr * 64 + fr; const int col0 = u.pn * BM + wc * 32 + 8 * fq;
        f32x4 gv[2][2];
#pragma unroll
        for (int bj = 0; bj < 2; ++bj)
#pragma unroll
            for (int n = 0; n < 2; ++n) gv[bj][n] = *(const f32x4*)(g + col0 + bj * HALF + 4 * n);
#pragma unroll
        for (int ai = 0; ai < 2; ++ai)
#pragma unroll
            for (int m = 0; m < 4; ++m) { const int row = row0 + ai * HALF + m * 16; const size_t off = (size_t)row * DM + col0; float ss = 0.f;
#pragma unroll
                for (int bj = 0; bj < 2; ++bj) { const f32x4 xa = *(const f32x4*)(x + off + bj * HALF), xb = *(const f32x4*)(x + off + bj * HALF + 4);
                    const f32x4 ha = xa + acc[ai][bj][m][0], hb = xb + acc[ai][bj][m][1];
                    *(f32x4*)(h + off + bj * HALF) = ha; *(f32x4*)(h + off + bj * HALF + 4) = hb;
                    ss += (ha[0] * ha[0] + ha[1] * ha[1]) + (ha[2] * ha[2] + ha[3] * ha[3]) + (hb[0] * hb[0] + hb[1] * hb[1]) + (hb[2] * hb[2] + hb[3] * hb[3]);
                    *(u32x4*)(hs + off + bj * HALF) = pack8(ha * gv[bj][0], hb * gv[bj][1]); }
                ss += __shfl_xor(ss, 16); ss += __shfl_xor(ss, 32);
                if (fq == 0) ssq[(size_t)row * 16 + u.pn * 4 + wc] = ss; }
    }
};
struct EpiDown {
    static constexpr bool PERM = true, AFTER_DRAIN = false;
    float* y; float* ssq;
    __device__ __forceinline__ void operator()(const f32x4 (&acc)[2][2][4][2], const Unit& u, int wr, int wc, int fr, int fq) const {
        const int row0 = u.pm * BM + wr * 64 + fr; const int col0 = u.pn * BM + wc * 32 + 8 * fq;
#pragma unroll
        for (int ai = 0; ai < 2; ++ai)
#pragma unroll
            for (int m = 0; m < 4; ++m) { const int row = row0 + ai * HALF + m * 16; const size_t off = (size_t)row * DM + col0; float ss = 0.f;
#pragma unroll
                for (int bj = 0; bj < 2; ++bj) { const f32x4 xa = *(const f32x4*)(y + off + bj * HALF), xb = *(const f32x4*)(y + off + bj * HALF + 4);
                    const f32x4 ha = xa + acc[ai][bj][m][0], hb = xb + acc[ai][bj][m][1];
                    *(f32x4*)(y + off + bj * HALF) = ha; *(f32x4*)(y + off + bj * HALF + 4) = hb;
                    ss += (ha[0] * ha[0] + ha[1] * ha[1]) + (ha[2] * ha[2] + ha[3] * ha[3]) + (hb[0] * hb[0] + hb[1] * hb[1]) + (hb[2] * hb[2] + hb[3] * hb[3]); }
                ss += __shfl_xor(ss, 16); ss += __shfl_xor(ss, 32);
                if (fq == 0) ssq[(size_t)row * 16 + u.pn * 4 + wc] = ss; }
    }
};
struct EpiUp {
    static constexpr bool PERM = true, AFTER_DRAIN = false;
    const float* ssq; const float* cw; const float* cb; bf16_t* act;
    __device__ __forceinline__ void operator()(const f32x4 (&acc)[2][2][4][2], const Unit& u, int wr, int wc, int fr, int fq) const {
        const int b = u.pm / 33, j = u.pm % 33; const int tb = 252 * j - 2 + 126 * wr;
        const int ch0 = u.pn * 128 + wc * 32 + 8 * fq;
        float rs[8];
#pragma unroll
        for (int g8 = 0; g8 < 8; ++g8) { int row = b * SEQ + tb + 16 * g8 + fr; row = row < 0 ? 0 : (row > M - 1 ? M - 1 : row);
            const f32x4* sp = (const f32x4*)(ssq + (size_t)row * 16); const f32x4 s0 = sp[0], s1 = sp[1], s2 = sp[2], s3 = sp[3];
            const float s = ((s0[0] + s0[1]) + (s0[2] + s0[3])) + ((s1[0] + s1[1]) + (s1[2] + s1[3])) + ((s2[0] + s2[1]) + (s2[2] + s2[3])) + ((s3[0] + s3[1]) + (s3[2] + s3[3]));
            rs[g8] = __builtin_amdgcn_rsqf(s * (1.0f / DM) + EPS);
            asm volatile("" : "+v"(rs[g8]) :: "memory"); __builtin_amdgcn_sched_barrier(0); }
        const int lane = fq * 16 + fr; const int src1 = ((lane & 48) | ((fr + 15) & 15)) * 4, src2 = ((lane & 48) | ((fr + 14) & 15)) * 4;
        const bool last1 = (fr == 15), last2 = (fr >= 14);
#pragma unroll
        for (int n = 0; n < 2; ++n) {
            const int ch = ch0 + 4 * n;
            const f32x4 wg0 = *(const f32x4*)(cw + ch), wg1 = *(const f32x4*)(cw + NUP + ch), wg2 = *(const f32x4*)(cw + 2 * NUP + ch), bg = *(const f32x4*)(cb + ch);
            const f32x4 wv0 = *(const f32x4*)(cw + DFF + ch), wv1 = *(const f32x4*)(cw + NUP + DFF + ch), wv2 = *(const f32x4*)(cw + 2 * NUP + DFF + ch), bvv = *(const f32x4*)(cb + DFF + ch);
            f32x4 pg = {0.f, 0.f, 0.f, 0.f}, pv = {0.f, 0.f, 0.f, 0.f};
#pragma unroll
            for (int g8 = 0; g8 < 8; ++g8) { const int ai = g8 >> 2, m = g8 & 3; const int qi = 16 * g8 + fr; const int t = tb + qi; const bool t1ok = t >= 1, t2ok = t >= 2;
                const f32x4 cg = acc[ai][0][m][n] * rs[g8], cv = acc[ai][1][m][n] * rs[g8]; f32x4 o;
#pragma unroll
                for (int e = 0; e < 4; ++e) {
                    float g1 = __builtin_bit_cast(float, __builtin_amdgcn_ds_bpermute(src1, __builtin_bit_cast(int, last1 ? pg[e] : cg[e])));
                    float g2 = __builtin_bit_cast(float, __builtin_amdgcn_ds_bpermute(src2, __builtin_bit_cast(int, last2 ? pg[e] : cg[e])));
                    g1 = t1ok ? g1 : 0.f; g2 = t2ok ? g2 : 0.f;
                    const float gate = silu_f(bg[e] + wg2[e] * cg[e] + wg1[e] * g1 + wg0[e] * g2);
                    float v1 = __builtin_bit_cast(float, __builtin_amdgcn_ds_bpermute(src1, __builtin_bit_cast(int, last1 ? pv[e] : cv[e])));
                    float v2 = __builtin_bit_cast(float, __builtin_amdgcn_ds_bpermute(src2, __builtin_bit_cast(int, last2 ? pv[e] : cv[e])));
                    v1 = t1ok ? v1 : 0.f; v2 = t2ok ? v2 : 0.f;
                    o[e] = gate * (bvv[e] + wv2[e] * cv[e] + wv1[e] * v1 + wv0[e] * v2); }
                if (qi >= 2 && t < SEQ) { typedef unsigned u32x2v __attribute__((ext_vector_type(2))); u32x2v w; w.x = cvt_pk_bf16(o[0], o[1]); w.y = cvt_pk_bf16(o[2], o[3]);
                    *(u32x2v*)(act + (size_t)(b * SEQ + t) * DFF + ch) = w; }
                pg = cg; pv = cv; __builtin_amdgcn_sched_barrier(0); }
        }
    }
};
template <class Epi, class Sched, class AMap, bool ALIGN_EPI = false, bool SP2 = false>
__device__ __forceinline__ void gemm_phase(PG8_LAS unsigned char* lds, const Gemm g, const Sched& S, const Epi& E) {
    const int tid = threadIdx.x, wid = __builtin_amdgcn_readfirstlane(tid >> 6), lane = tid & 63, wr = wid >> 2, wc = wid & 3, fr = lane & 15, fq = lane >> 4;
    const int K = g.K, nt = K / BK;
    unsigned voffA[2], voffB[2];
#pragma unroll
    for (int i = 0; i < 2; ++i) { int R, C; stage_rc(tid * 16 + i * 8192, R, C); const int Rb = Epi::PERM ? ((R & ~31) + perm32(R & 31)) : R;
        voffA[i] = (unsigned)(AMap::rowmap(R) * K + C) * 2u; voffB[i] = (unsigned)(Rb * K + C) * 2u; }
    const size_t kstep = (size_t)(BK * 2);
    const size_t hstepA = (size_t)AMap::HALF_ROWS * K * 2, hstepB = (size_t)HALF * K * 2;
    const size_t tstepB = 2 * hstepB;
    const unsigned ldsw = (unsigned)wid * 1024u;
    const int aoff = lds_byte(wr * 64 + fr, fq * 8), boff = lds_byte(wc * 32 + fr, fq * 8);
#define PG8_SA(b, h) (((b) * 2 + (h)) * HTB)
#define PG8_SB(b, h) ((4 + (b) * 2 + (h)) * HTB)
#define PG8_STAGE(bufoff, gbase, voff) do { _Pragma("unroll") for (int _i = 0; _i < 2; ++_i) \
        __builtin_amdgcn_global_load_lds((const unsigned*)((const char*)(gbase) + (voff)[_i]), (PG8_LAS unsigned*)(lds + (bufoff) + ldsw + _i * 8192), 16, 0, 0); } while (0)
#define PG8_LDA(dst, b, h) do { _Pragma("unroll") for (int m = 0; m < 4; ++m) _Pragma("unroll") for (int k = 0; k < 2; ++k) dst[m][k] = *(const PG8_LAS bf16x8*)(lds + PG8_SA(b, h) + aoff + m * 2048 + k * 1024); } while (0)
#define PG8_LDB(dst, b, h) do { _Pragma("unroll") for (int n = 0; n < 2; ++n) _Pragma("unroll") for (int k = 0; k < 2; ++k) dst[n][k] = *(const PG8_LAS bf16x8*)(lds + PG8_SB(b, h) + boff + n * 2048 + k * 1024); } while (0)
#define PG8_MMA(ai, bj, At, Bt) do { __builtin_amdgcn_s_setprio(1); _Pragma("unroll") for (int m = 0; m < 4; ++m) _Pragma("unroll") for (int n = 0; n < 2; ++n) _Pragma("unroll") for (int k = 0; k < 2; ++k) \
        acc[ai][bj][m][n] = __builtin_amdgcn_mfma_f32_16x16x32_bf16(Bt[n][k], At[m][k], acc[ai][bj][m][n], 0, 0, 0); __builtin_amdgcn_s_setprio(0); } while (0)
#define PG8_WAIT_V(n) asm volatile("s_waitcnt vmcnt(" #n ")" ::: "memory")
#define PG8_WAIT_L(n) asm volatile("s_waitcnt lgkmcnt(" #n ")" ::: "memory")
#define PG8_BAR __builtin_amdgcn_s_barrier()
#define PG8_SCHED __builtin_amdgcn_sched_barrier(0)
    Unit cur, nxt; int ui = 0;
    if (!S.next(0, cur)) return;
    f32x4 acc[2][2][4][2];
#pragma unroll
    for (int a = 0; a < 2; ++a)
#pragma unroll
        for (int b = 0; b < 2; ++b)
#pragma unroll
            for (int m = 0; m < 4; ++m)
#pragma unroll
                for (int n = 0; n < 2; ++n) acc[a][b][m][n] = (f32x4){0.f, 0.f, 0.f, 0.f};
    bf16x8 At[4][2], B0[2][2], B1[2][2];
    const char* cA = (const char*)g.A + (long)AMap::tile_row(cur.pm) * K * 2; const char* cB = (const char*)g.Bt + (size_t)cur.pn * tstepB;
    S.a_ready(cur);
    if constexpr (SP2) {
        PG8_STAGE(PG8_SB(0, 0), cB, voffB); PG8_STAGE(PG8_SB(0, 1), cB + hstepB, voffB); PG8_STAGE(PG8_SA(0, 0), cA, voffA); PG8_STAGE(PG8_SA(0, 1), cA + hstepA, voffA);
        if (wr == 1) PG8_BAR;
        PG8_WAIT_V(2); PG8_BAR;
        PG8_STAGE(PG8_SB(1, 0), cB + kstep, voffB); PG8_STAGE(PG8_SA(1, 0), cA + kstep, voffA); PG8_STAGE(PG8_SB(1, 1), cB + hstepB + kstep, voffB);
        PG8_WAIT_V(6); PG8_BAR;
    } else {
        PG8_STAGE(PG8_SB(0, 0), cB, voffB); PG8_STAGE(PG8_SA(0, 0), cA, voffA); PG8_STAGE(PG8_SB(0, 1), cB + hstepB, voffB); PG8_STAGE(PG8_SA(0, 1), cA + hstepA, voffA);
        if (wr == 1) PG8_BAR;
        PG8_WAIT_V(4); PG8_BAR;
        PG8_STAGE(PG8_SB(1, 0), cB + kstep, voffB); PG8_STAGE(PG8_SA(1, 0), cA + kstep, voffA); PG8_STAGE(PG8_SB(1, 1), cB + hstepB + kstep, voffB);
        PG8_WAIT_V(6); PG8_BAR;
    }
    for (;;) {
        const bool has_next = S.next(ui + 1, nxt);
        const char* nA = has_next ? (const char*)g.A + (long)AMap::tile_row(nxt.pm) * K * 2 : cA; const char* nB = has_next ? (const char*)g.Bt + (size_t)nxt.pn * tstepB : cB;
        for (int t = 0; t < nt; t += 2) {
            const bool last = (t == nt - 2);
            const char* a1 = cA + (size_t)(t + 1) * kstep;
            const char* a2 = last ? nA : cA + (size_t)(t + 2) * kstep; const char* b2 = last ? nB : cB + (size_t)(t + 2) * kstep;
            const char* a3 = a2 + kstep; const char* b3 = b2 + kstep;
            if (last && has_next) S.a_ready(nxt);
            if constexpr (SP2) {
            PG8_LDB(B0, 0, 0); PG8_LDB(B1, 0, 1); PG8_SCHED; PG8_LDA(At, 0, 0); PG8_STAGE(PG8_SA(1, 1), a1 + hstepA, voffA);
            PG8_WAIT_V(8); PG8_WAIT_L(0); PG8_BAR; PG8_MMA(0, 0, At, B0); PG8_MMA(0, 1, At, B1); PG8_BAR; PG8_SCHED;
            PG8_LDA(At, 0, 1); PG8_STAGE(PG8_SB(0, 0), b2, voffB); PG8_STAGE(PG8_SB(0, 1), b2 + hstepB, voffB); PG8_STAGE(PG8_SA(0, 0), a2, voffA);
            PG8_WAIT_V(8); PG8_WAIT_L(0); PG8_BAR; PG8_MMA(1, 0, At, B0); PG8_MMA(1, 1, At, B1); PG8_BAR; PG8_SCHED;
            PG8_LDB(B0, 1, 0); PG8_LDB(B1, 1, 1); PG8_SCHED; PG8_LDA(At, 1, 0); PG8_STAGE(PG8_SA(0, 1), a2 + hstepA, voffA);
            PG8_WAIT_V(8); PG8_WAIT_L(0); PG8_BAR; PG8_MMA(0, 0, At, B0); PG8_MMA(0, 1, At, B1); PG8_BAR; PG8_SCHED;
            PG8_LDA(At, 1, 1); PG8_STAGE(PG8_SB(1, 0), b3, voffB); PG8_STAGE(PG8_SB(1, 1), b3 + hstepB, voffB); PG8_STAGE(PG8_SA(1, 0), a3, voffA);
            PG8_WAIT_V(8); PG8_WAIT_L(0); PG8_BAR; PG8_MMA(1, 0, At, B0); PG8_MMA(1, 1, At, B1); PG8_BAR; PG8_SCHED;
            } else {
            PG8_LDB(B0, 0, 0); PG8_SCHED; PG8_LDA(At, 0, 0); PG8_STAGE(PG8_SA(1, 1), a1 + hstepA, voffA);
            PG8_WAIT_L(8); PG8_BAR; PG8_WAIT_L(0); PG8_MMA(0, 0, At, B0); PG8_BAR; PG8_SCHED;
            PG8_LDB(B1, 0, 1); PG8_STAGE(PG8_SB(0, 0), b2, voffB);
            PG8_BAR; PG8_WAIT_L(0); PG8_MMA(0, 1, At, B1); PG8_BAR;
            PG8_LDA(At, 0, 1); PG8_STAGE(PG8_SA(0, 0), a2, voffA);
            PG8_BAR; PG8_WAIT_L(0); PG8_MMA(1, 0, At, B0); PG8_BAR; PG8_SCHED;
            PG8_STAGE(PG8_SB(0, 1), b2 + hstepB, voffB);
            PG8_WAIT_V(6); PG8_BAR; PG8_MMA(1, 1, At, B1); PG8_BAR;
            PG8_LDB(B0, 1, 0); PG8_SCHED; PG8_LDA(At, 1, 0); PG8_STAGE(PG8_SA(0, 1), a2 + hstepA, voffA);
            PG8_WAIT_L(8); PG8_BAR; PG8_WAIT_L(0); PG8_MMA(0, 0, At, B0); PG8_BAR; PG8_SCHED;
            PG8_LDB(B1, 1, 1); PG8_STAGE(PG8_SB(1, 0), b3, voffB);
            PG8_BAR; PG8_WAIT_L(0); PG8_MMA(0, 1, At, B1); PG8_BAR;
            PG8_LDA(At, 1, 1); PG8_STAGE(PG8_SA(1, 0), a3, voffA);
            PG8_BAR; PG8_WAIT_L(0); PG8_MMA(1, 0, At, B0); PG8_BAR; PG8_SCHED;
            PG8_STAGE(PG8_SB(1, 1), b3 + hstepB, voffB);
            PG8_WAIT_V(6); PG8_BAR; PG8_MMA(1, 1, At, B1); PG8_BAR;
            }
        }
        if constexpr (ALIGN_EPI) { if (wr == 0) PG8_BAR; }
        if constexpr (!Epi::AFTER_DRAIN) { E(acc, cur, wr, wc, fr, fq); S.done(cur); }
        if (!has_next) break;
#pragma unroll
        for (int a = 0; a < 2; ++a)
#pragma unroll
            for (int b = 0; b < 2; ++b)
#pragma unroll
                for (int m = 0; m < 4; ++m)
#pragma unroll
                    for (int n = 0; n < 2; ++n) acc[a][b][m][n] = (f32x4){0.f, 0.f, 0.f, 0.f};
        cur = nxt; cA = nA; cB = nB; ++ui;
        if constexpr (ALIGN_EPI) { if (wr == 1) PG8_BAR; }
    }
    PG8_WAIT_V(0);
    if constexpr (!ALIGN_EPI) { if (wr == 0) PG8_BAR; }
    PG8_BAR;
    if constexpr (Epi::AFTER_DRAIN) { E.fused(acc, cur, wr, wc, fr, fq, lds, wid, lane); S.done(cur); }
#undef PG8_SA
#undef PG8_SB
#undef PG8_STAGE
#undef PG8_LDA
#undef PG8_LDB
#undef PG8_MMA
#undef PG8_WAIT_V
#undef PG8_WAIT_L
#undef PG8_BAR
#undef PG8_SCHED
}
}

constexpr int NWAVES = 8;
constexpr size_t MiB = 1u << 20;
constexpr size_t WS_CTL = 0, CTL_ZERO_BYTES = 1 * MiB;
constexpr size_t WS_WIN = 2 * MiB, WS_WOUT = 9 * MiB, WS_WUP = 11 * MiB, WS_WDOWN = 22 * MiB;
constexpr size_t WS_ROPE = 28 * MiB, WS_KMEAN = 30 * MiB, WS_SSQA = 31 * MiB, WS_SSQB = 32 * MiB;
constexpr size_t WS_XN = 34 * MiB + 65536;
constexpr size_t WS_Q = 68 * MiB, WS_K = 84 * MiB, WS_V = 100 * MiB, WS_GQ = 116 * MiB, WS_GK = 124 * MiB, WS_GV = 132 * MiB, WS_SR = 148 * MiB, WS_LOGA = 164 * MiB, WS_ADEC = 180 * MiB;
constexpr size_t WS_YMIX = 196 * MiB;
constexpr size_t WS_ACT = 68 * MiB;
constexpr size_t WS_END = 256 * MiB;
constexpr int CW_BAR = 4096;

constexpr int RING_OFF = 0, RING_BYTES = 131072;
constexpr int LDSCTL_OFF = RING_BYTES, MISC_OFF = LDSCTL_OFF + 320;
constexpr int LDS_BYTES = 147456;

#define GAS __attribute__((address_space(1)))
#define LAS __attribute__((address_space(3)))
typedef unsigned v4u __attribute__((ext_vector_type(4)));
typedef float f32x4 __attribute__((ext_vector_type(4)));
typedef GAS unsigned gu32;
#define RLX_AGENT __ATOMIC_RELAXED, __HIP_MEMORY_SCOPE_AGENT
#define LDS_WAIT() asm volatile("s_waitcnt lgkmcnt(0)" ::: "memory")
#define VM_WAIT() asm volatile("s_waitcnt vmcnt(0)" ::: "memory")
__device__ __forceinline__ unsigned pk2(float lo, float hi) { return f2bf(lo) | (f2bf(hi) << 16); }
#define XB_TMO      128
#define XB_XCNT(j)  (256  + 64 * (j))
#define XB_XSUB(j)  (1280 + 64 * (j))
#define XB_XGEN(j)  (2304 + 64 * (j))
#define XB_TOP      3328
#define XB_TOPGEN   3392
#define XCD_BAR_WORDS 3456
#define XB_SPIN_CAP (1u << 18)

__device__ __forceinline__ unsigned xb_ld(unsigned* p)              { return __hip_atomic_load(p, __ATOMIC_RELAXED, __HIP_MEMORY_SCOPE_AGENT); }
__device__ __forceinline__ unsigned xb_add(unsigned* p, unsigned v) { return __hip_atomic_fetch_add(p, v, __ATOMIC_RELAXED, __HIP_MEMORY_SCOPE_AGENT); }
__device__ __forceinline__ unsigned xb_xcc_id() { return (unsigned)__builtin_amdgcn_s_getreg((3 << 11) | 20) & 0xFu; }
#define XB_SPIN(cond, bar) do { unsigned _sp = 0; while (cond) { __builtin_amdgcn_s_sleep(1); \
    if ((++_sp & 255u) == 0u) { if (xb_ld(&(bar)[XB_TMO])) break; if (_sp > XB_SPIN_CAP) { atomicAdd(&(bar)[XB_TMO], 1u); break; } } } } while (0)

struct XcdBarrier {
    unsigned* bar; unsigned x;
    volatile LAS unsigned* st;
};

__device__ __forceinline__ XcdBarrier xcd_barrier_post(unsigned* bar, volatile LAS unsigned* st) {
    XcdBarrier b; b.bar = bar; b.x = xb_xcc_id(); b.st = st;
    if (threadIdx.x == 0) (void)xb_add(&bar[XB_XCNT(b.x)], 1u);
    return b;
}
__device__ __forceinline__ void xcd_barrier_complete(unsigned* bar, unsigned x, unsigned& nloc, unsigned& nx) {
    const unsigned G = gridDim.x * gridDim.y * gridDim.z;
    unsigned sum, cnt, mine, sp = 0u;
    for (;;) {
        sum = 0u; cnt = 0u; mine = 0u;
#pragma unroll
        for (unsigned j = 0; j < 16; ++j) { const unsigned c = xb_ld(&bar[XB_XCNT(j)]); sum += c; cnt += (c > 0u) ? 1u : 0u; mine = (j == x) ? c : mine; }
        if (sum == G) break;
        __builtin_amdgcn_s_sleep(1);
        if ((++sp & 255u) == 0u) { if (xb_ld(&bar[XB_TMO])) break; if (sp > XB_SPIN_CAP) { atomicAdd(&bar[XB_TMO], 1u); break; } }
    }
    nloc = mine > 0u ? mine : 1u; nx = cnt > 0u ? cnt : 1u;
}

__device__ __forceinline__ void xcd_barrier(const XcdBarrier& b) {
    asm volatile("s_waitcnt vmcnt(0)" ::: "memory");
    __syncthreads();
    if (threadIdx.x == 0) {
        unsigned* bar = b.bar;
        __builtin_amdgcn_s_waitcnt(0);
        unsigned nloc = b.st[0], nx = b.st[1];
        if (nloc == 0u) { xcd_barrier_complete(bar, b.x, nloc, nx); b.st[0] = nloc; b.st[1] = nx; }
        const unsigned old = xb_add(&bar[XB_XSUB(b.x)], 1u);
        const unsigned gen = old / nloc;
        if (old + 1u == (gen + 1u) * nloc) {
            __builtin_amdgcn_fence(__ATOMIC_RELEASE, "agent");
            asm volatile("s_waitcnt vmcnt(0)" ::: "memory");
            const unsigned og = xb_add(&bar[XB_TOP], 1u);
            const unsigned tg = og / nx;
            if (og + 1u == (tg + 1u) * nx) xb_add(&bar[XB_TOPGEN], 1u);
            else XB_SPIN(xb_ld(&bar[XB_TOPGEN]) == tg, bar);
            __builtin_amdgcn_fence(__ATOMIC_ACQUIRE, "agent");
            xb_add(&bar[XB_XGEN(b.x)], 1u);
            asm volatile("s_waitcnt vmcnt(0)" ::: "memory");
        } else {
            XB_SPIN(xb_ld(&bar[XB_XGEN(b.x)]) == gen, bar);
            __builtin_amdgcn_fence(__ATOMIC_ACQUIRE, "agent");
            asm volatile("s_waitcnt vmcnt(0)" ::: "memory");
        }
    }
    __syncthreads();
}

struct Frame {
    LAS unsigned char* lds; volatile LAS unsigned* MISC; gu32* ctl;
    int tid, lane, wave, vcu, G;
};
template <int CMAP> __device__ __forceinline__ int col_map(int n) {
    if (CMAP == 1) { return (n < 1024) ? ((n & ~63) + ((n & 1) << 5) + ((n & 63) >> 1)) : n; }
    if (CMAP == 2) { const int pn = n >> 8, jj = n & 255; return (jj < 128) ? (pn * 128 + jj) : (DFF + pn * 128 + (jj - 128)); }
    return n;
}
template <int CMAP> __device__ __forceinline__ void p0_transpose_item(const float* W, int K, int ldw, int Nout, bf16_t* WT, LAS float* scr, int item, int lane) {
    const int nblk = Nout / 32, kb = item / nblk, nb = item % nblk, k0 = 64 * kb, n0 = 32 * nb;
    const int sc = col_map<CMAP>(n0 + (lane & 31));
#pragma unroll 8
    for (int i = 0; i < 32; ++i) { const int kk = 2 * i + (lane >> 5); scr[kk * 33 + (lane & 31)] = W[(size_t)(k0 + kk) * ldw + sc]; }
    LDS_WAIT(); asm volatile("" ::: "memory");
    const int c = lane & 7;
#pragma unroll
    for (int j = 0; j < 4; ++j) { const int n = (lane >> 3) + 8 * j; const LAS float* s = scr + (8 * c) * 33 + n;
        v4u o; o.x = pk2(s[0 * 33], s[1 * 33]); o.y = pk2(s[2 * 33], s[3 * 33]); o.z = pk2(s[4 * 33], s[5 * 33]); o.w = pk2(s[6 * 33], s[7 * 33]);
        *(GAS v4u*)(WT + (size_t)(n0 + n) * K + k0 + 8 * c) = o; }
    LDS_WAIT(); asm volatile("" ::: "memory");
}

struct Args { const float* in[13]; float* out; unsigned char* ws; int ph_lo, ph_hi, li, pad; };

__device__ __forceinline__ void p0_prologue(Frame& F, const Args& a) {
    unsigned char* ws = a.ws;
    LAS float* scr = (LAS float*)(F.lds + RING_OFF + F.wave * 16384);
    const int gw = F.vcu * NWAVES + F.wave, NGW = F.G * NWAVES;
    const float* w_in = a.in[2]; const float* w_gate_up = a.in[3]; const float* w_out = a.in[6]; const float* w_up = a.in[8]; const float* w_down = a.in[11];
    bf16_t* WIN = (bf16_t*)(ws + WS_WIN); bf16_t* WOUT = (bf16_t*)(ws + WS_WOUT); bf16_t* WUP = (bf16_t*)(ws + WS_WUP); bf16_t* WDOWN = (bf16_t*)(ws + WS_WDOWN);
    constexpr int I_IN = (DM / 64) * (3072 / 32), I_OUT = (DM / 64) * (DM / 32), I_UP = (DM / 64) * (NUP / 32), I_DOWN = (DFF / 64) * (DM / 32);
    constexpr int NITEMS = I_IN + I_OUT + I_UP + I_DOWN;
    for (int it = gw; it < NITEMS; it += NGW) {
        int r = it;
        if (r < I_IN) { p0_transpose_item<1>(w_in, DM, NIN, 3072, WIN, scr, r, F.lane); continue; } r -= I_IN;
        if (r < I_OUT) { p0_transpose_item<0>(w_out, DM, DM, DM, WOUT, scr, r, F.lane); continue; } r -= I_OUT;
        if (r < I_UP) { p0_transpose_item<2>(w_up, DM, NUP, NUP, WUP, scr, r, F.lane); continue; } r -= I_UP;
        p0_transpose_item<0>(w_down, DFF, DM, DM, WDOWN, scr, r, F.lane);
    }
    const int gt = gw * 64 + F.lane, NGT = NGW * 64;
    for (int idx = gt; idx < 256 * 128; idx += NGT) { const int c = idx & 255, k0 = (idx >> 8) * 8; float wg[16];
#pragma unroll
        for (int r = 0; r < 16; ++r) wg[r] = w_gate_up[r * 256 + c];
        float o[8];
#pragma unroll
        for (int e = 0; e < 8; ++e) { const f32x4* wp = (const f32x4*)(w_in + (size_t)(k0 + e) * NIN + 3072); float s = 0.f;
#pragma unroll
            for (int r4 = 0; r4 < 4; ++r4) { const f32x4 w4 = wp[r4]; s += w4[0] * wg[4 * r4] + w4[1] * wg[4 * r4 + 1] + w4[2] * wg[4 * r4 + 2] + w4[3] * wg[4 * r4 + 3]; }
            o[e] = s; }
        v4u w; w.x = pk2(o[0], o[1]); w.y = pk2(o[2], o[3]); w.z = pk2(o[4], o[5]); w.w = pk2(o[6], o[7]);
        *(GAS v4u*)(WIN + (size_t)(3072 + c) * DM + k0) = w; }
    { float2* tab = (float2*)(ws + WS_ROPE);
      for (int idx = gt; idx < SEQ * 32; idx += NGT) { const int pos = idx >> 5, i = idx & 31; const double rev = (double)pos * INV_FREQ[i] * 0.15915494309189535; const float f = (float)(rev - __builtin_rint(rev));
          tab[idx] = make_float2(__builtin_amdgcn_cosf(f), __builtin_amdgcn_sinf(f)); } }
    { float* km = (float*)(ws + WS_KMEAN); for (int idx = gt; idx < NB * 32 * 512; idx += NGT) km[idx] = 0.f; }
    { const float* x = a.in[0]; const float* g = a.in[1]; bf16_t* XN = (bf16_t*)(ws + WS_XN);
      for (int m = gw; m < M; m += NGW) { const GAS f32x4* xr = (const GAS f32x4*)(x + (size_t)m * DM) + F.lane; f32x4 v[4]; float s = 0.f;
#pragma unroll
          for (int j = 0; j < 4; ++j) { v[j] = xr[64 * j]; s += (v[j].x * v[j].x + v[j].y * v[j].y) + (v[j].z * v[j].z + v[j].w * v[j].w); }
          const float rstd = 1.f / sqrtf(wave_sum(s) * (1.f / DM) + EPS);
          GAS unsigned long long* o8 = (GAS unsigned long long*)(XN + (size_t)m * DM) + F.lane;
#pragma unroll
          for (int j = 0; j < 4; ++j) { const f32x4 gg = ((const GAS f32x4*)g)[64 * j + F.lane];
              o8[64 * j] = (unsigned long long)pk2(v[j].x * rstd * gg.x, v[j].y * rstd * gg.y) | ((unsigned long long)pk2(v[j].z * rstd * gg.z, v[j].w * rstd * gg.w) << 32); } } }
}
__device__ __forceinline__ void p_final(Frame& F, const Args& a) {
    const int gw = F.vcu * NWAVES + F.wave, NGW = F.G * NWAVES; const float* g = a.in[12]; const float* ssq = (const float*)(a.ws + WS_SSQB);
    for (int m = gw; m < M; m += NGW) { GAS f32x4* yr = (GAS f32x4*)(a.out + (size_t)m * DM) + F.lane;
        const float p = (F.lane < 16) ? ssq[(size_t)m * 16 + F.lane] : 0.f; const float rstd = 1.f / sqrtf(wave_sum(p) * (1.f / DM) + EPS);
#pragma unroll
        for (int j = 0; j < 4; ++j) { const f32x4 v = yr[64 * j]; const f32x4 gg = ((const GAS f32x4*)g)[64 * j + F.lane]; yr[64 * j] = v * rstd * gg; } }
}

__global__ void __launch_bounds__(NWAVES * 64, 2) skel_fwd(Args args) {
    extern __shared__ __attribute__((aligned(16))) unsigned char lds[];
    Frame F;
    F.lds = (LAS unsigned char*)lds; F.MISC = (volatile LAS unsigned*)(F.lds + MISC_OFF);
    F.tid = threadIdx.x; F.lane = F.tid & 63; F.wave = __builtin_amdgcn_readfirstlane(F.tid >> 6);
    F.G = gridDim.x; { const int bx = blockIdx.x; F.vcu = (F.G % 8 == 0) ? (bx % 8) * (F.G / 8) + bx / 8 : bx; }
    unsigned char* ws = args.ws; F.ctl = (gu32*)(ws + WS_CTL);
    for (int u = F.tid; u < (LDS_BYTES - LDSCTL_OFF) / 4; u += NWAVES * 64) ((LAS unsigned*)(F.lds + LDSCTL_OFF))[u] = 0u;
    __syncthreads();
    XcdBarrier bar = xcd_barrier_post((unsigned*)(F.ctl + CW_BAR) + args.li * XCD_BAR_WORDS, F.MISC + 8);
    const int lo = args.ph_lo, hi = args.ph_hi;
#define IN(k) (lo <= (k) && (k) < hi)
#define BOTH(k) (IN(k) && IN((k) + 1))
#define GRID_BAR() xcd_barrier(bar)
    bf16_t* XN = (bf16_t*)(ws + WS_XN);
    if (IN(0)) { p0_prologue(F, args); if (BOTH(0)) GRID_BAR(); }
    if (IN(1)) {
        pg8::Gemm g{XN, (const bf16_t*)(ws + WS_WIN), M, NINP, DM}; pg8::StaticOrder S; S.init(M / 256, NINP / 256, F.G, (int)blockIdx.x);
        pg8::EpiInProj E{(bf16_t*)(ws + WS_Q), (bf16_t*)(ws + WS_K), (bf16_t*)(ws + WS_V), (bf16_t*)(ws + WS_GQ), (bf16_t*)(ws + WS_GK), (bf16_t*)(ws + WS_GV), (bf16_t*)(ws + WS_SR),
                         (float*)(ws + WS_LOGA), (float*)(ws + WS_KMEAN), (const float*)(ws + WS_ROPE), args.in[4]};
        pg8::gemm_phase<pg8::EpiInProj, pg8::StaticOrder, pg8::AMapStd, true, true>(F.lds + RING_OFF, g, S, E);
        if (BOTH(1)) GRID_BAR();
    }
    if (IN(2)) { if (BOTH(2)) GRID_BAR(); }
    if (IN(3)) {
        pg8::Gemm g{(const bf16_t*)(ws + WS_YMIX), (const bf16_t*)(ws + WS_WOUT), M, DM, DM}; pg8::StaticOrder S; S.init(M / 256, DM / 256, F.G, (int)blockIdx.x);
        pg8::EpiOutProj E{args.in[0], args.out, XN, args.in[7], (float*)(ws + WS_SSQA)};
        pg8::gemm_phase<pg8::EpiOutProj, pg8::StaticOrder, pg8::AMapStd, true, true>(F.lds + RING_OFF, g, S, E);
        if (BOTH(3)) GRID_BAR();
    }
    if (IN(4)) {
        pg8::Gemm g{XN, (const bf16_t*)(ws + WS_WUP), M, NUP, DM}; pg8::StaticOrder S; S.init(66, NUP / 256, F.G, (int)blockIdx.x);
        pg8::EpiUp E{(const float*)(ws + WS_SSQA), args.in[9], args.in[10], (bf16_t*)(ws + WS_ACT)};
        pg8::gemm_phase<pg8::EpiUp, pg8::StaticOrder, pg8::AMapConv, true, true>(F.lds + RING_OFF, g, S, E);
        if (BOTH(4)) GRID_BAR();
    }
    if (IN(5)) {
        pg8::Gemm g{(const bf16_t*)(ws + WS_ACT), (const bf16_t*)(ws + WS_WDOWN), M, DM, DFF}; pg8::StaticOrder S; S.init(M / 256, DM / 256, F.G, (int)blockIdx.x);
        pg8::EpiDown E{args.out, (float*)(ws + WS_SSQB)};
        pg8::gemm_phase<pg8::EpiDown, pg8::StaticOrder, pg8::AMapStd, true, true>(F.lds + RING_OFF, g, S, E);
        if (BOTH(5)) GRID_BAR();
    }
    if (IN(6)) { p_final(F, args); }
#undef IN
#undef BOTH
#undef GRID_BAR
}

__global__ __launch_bounds__(256) void adec_k(const float* loga, float* adec) { const size_t i = (size_t)blockIdx.x * 256 + threadIdx.x; adec[i] = expf(loga[i]); }

extern "C" void kernel_launch(void* const* d_in, const int* in_sizes, int n_in, void* d_out, int out_size, void* d_ws, size_t ws_size, hipStream_t stream) {
    static int grid = 0;
    if (grid == 0) {
        if (n_in != 13 || in_sizes[0] != M * DM || out_size != M * DM || ws_size < WS_END) { fprintf(stderr, "kernel_launch: unexpected shapes / workspace (%d inputs, ws %zu)\n", n_in, ws_size); grid = -1; return; }
        int dev = 0, cus = 0, per_cu = 0;
        if (hipGetDevice(&dev) != hipSuccess || hipDeviceGetAttribute(&cus, hipDeviceAttributeMultiprocessorCount, dev) != hipSuccess) { grid = -1; return; }
        if (hipFuncSetAttribute((const void*)skel_fwd, hipFuncAttributeMaxDynamicSharedMemorySize, LDS_BYTES) != hipSuccess) { fprintf(stderr, "kernel_launch: hipFuncSetAttribute failed\n"); grid = -1; return; }
        if (hipOccupancyMaxActiveBlocksPerMultiprocessor(&per_cu, (const void*)skel_fwd, NWAVES * 64, LDS_BYTES) != hipSuccess || per_cu < 1) { fprintf(stderr, "kernel_launch: occupancy query says %d\n", per_cu); }
        (void)hipGetLastError();
        grid = cus;
    }
    if (grid < 0) return;
    unsigned char* ws = (unsigned char*)d_ws;
    hipMemsetAsync(ws + WS_CTL, 0, CTL_ZERO_BYTES, stream);
    Args a{};
    for (int i = 0; i < 13; ++i) a.in[i] = (const float*)d_in[i];
    a.out = (float*)d_out; a.ws = ws;
    a.ph_lo = 0; a.ph_hi = 2; a.li = 0;
    hipLaunchKernelGGL(skel_fwd, dim3(grid), dim3(NWAVES * 64), LDS_BYTES, stream, a);
    IF1 f; f.q = (bf16_t*)(ws + WS_Q); f.k = (bf16_t*)(ws + WS_K); f.v = (bf16_t*)(ws + WS_V); f.gq = (bf16_t*)(ws + WS_GQ); f.gk = (bf16_t*)(ws + WS_GK); f.gv = (bf16_t*)(ws + WS_GV);
    f.sr = (bf16_t*)(ws + WS_SR); f.loga = (float*)(ws + WS_LOGA); f.adec = (float*)(ws + WS_ADEC); f.kmean = (float*)(ws + WS_KMEAN); f.rope = (const float2*)(ws + WS_ROPE);
    bf16_t* ymix = (bf16_t*)(ws + WS_YMIX); float* oraw = (float*)d_out;
    adec_k<<<M * 256 / 256, 256, 0, stream>>>(f.loga, f.adec);
    moba_naive_k<<<M * 8 / 4, 256, 0, stream>>>(f, ymix);
    gla_rec_k<<<NB * 4, 128, 0, stream>>>(f, oraw);
    gla_norm_k<<<M, 256, 0, stream>>>(oraw, (const float*)d_in[5], f.sr, ymix);
    a.ph_lo = 3; a.ph_hi = 7; a.li = 1;
    hipLaunchKernelGGL(skel_fwd, dim3(grid), dim3(NWAVES * 64), LDS_BYTES, stream, a);
}
```

```cpp
#include <hip/hip_runtime.h>
#include <cstdio>
#include <cstdint>

typedef unsigned short bf16_t;
constexpr int NB = 2, SEQ = 8192, DM = 1024, M = NB * SEQ;
constexpr int NIN = 3088, DFF = 2816, NUP = 2 * DFF, NINP = 3328;
constexpr float EPS = 1e-6f;
constexpr float C2 = 0.18033688011112042f;

__device__ __forceinline__ unsigned f2bf(float f) { unsigned u = __builtin_bit_cast(unsigned, f); return (u + 0x7fffu + ((u >> 16) & 1u)) >> 16; }
__device__ __forceinline__ float bf2f(bf16_t h) { return __builtin_bit_cast(float, (unsigned)h << 16); }

__device__ const double INV_FREQ[32] = {1.0, 0.7498942093324559, 0.5623413251903491, 0.4216965034285822, 0.31622776601683794, 0.23713737056616552, 0.1778279410038923, 0.1333521432163324, 0.1, 0.07498942093324558, 0.05623413251903491, 0.042169650342858224, 0.03162277660168379, 0.023713737056616554, 0.01778279410038923, 0.01333521432163324, 0.01, 0.007498942093324558, 0.005623413251903491, 0.004216965034285823, 0.0031622776601683794, 0.0023713737056616554, 0.0017782794100389228, 0.001333521432163324, 0.001, 0.0007498942093324559, 0.0005623413251903491, 0.00042169650342858224, 0.00031622776601683794, 0.00023713737056616554, 0.00017782794100389227, 0.0001333521432163324};

__device__ __forceinline__ float wave_sum(float v) {
#pragma unroll
    for (int o = 1; o < 64; o <<= 1) v += __shfl_xor(v, o);
    return v;
}

struct IF1 { bf16_t *q, *k, *v, *gq, *gk, *gv, *sr; float *loga, *adec, *kmean; const float2* rope; };
__device__ __forceinline__ void moba_pair(const IF1& a, bf16_t* ymix, int gw, int lane) {
    const int row = gw >> 3, h = gw & 7, b = row / SEQ, t = row % SEQ, own = t >> 8;
    const bf16_t* qp = a.q + (size_t)row * 512 + 64 * h;
    float gate = -INFINITY;
    if (lane < own) { const float* km = a.kmean + ((size_t)(b * 32 + lane) * 8 + h) * 64; float s = 0.f;
        for (int p = 0; p < 64; ++p) s += bf2f(qp[p]) * km[p]; gate = s; }
    int selb[4]; int nsel = 0;
#pragma unroll
    for (int it = 0; it < 3; ++it) {
        float mv = gate; int mi = lane;
#pragma unroll
        for (int o = 1; o < 64; o <<= 1) { const float ov = __shfl_xor(mv, o); const int oi = __shfl_xor(mi, o); if (ov > mv || (ov == mv && oi < mi)) { mv = ov; mi = oi; } }
        if (mv > -INFINITY) { selb[it] = mi; nsel = it + 1; if (lane == mi) gate = -INFINITY; } else selb[it] = -1;
    }
    selb[3] = own;
    float sc[4][4];
    float mx = -INFINITY;
#pragma unroll
    for (int c = 0; c < 4; ++c) {
        const int blk = (c < 3) ? selb[c] : own; const bool valid = (c == 3) || (c < nsel);
#pragma unroll
        for (int u = 0; u < 4; ++u) { float s = -INFINITY;
            if (valid) { const int key = blk * 256 + u * 64 + lane;
                if (c < 3 || key <= t) { const bf16_t* kp = a.k + (size_t)(b * SEQ + key) * 512 + 64 * h; float d = 0.f;
                    for (int p = 0; p < 64; ++p) d += bf2f(qp[p]) * bf2f(kp[p]); s = d; } }
            sc[c][u] = s; mx = fmaxf(mx, s); }
    }
#pragma unroll
    for (int o = 1; o < 64; o <<= 1) mx = fmaxf(mx, __shfl_xor(mx, o));
    float l = 0.f;
#pragma unroll
    for (int c = 0; c < 4; ++c)
#pragma unroll
        for (int u = 0; u < 4; ++u) { const float pv = (sc[c][u] == -INFINITY) ? 0.f : exp2f(sc[c][u] - mx); sc[c][u] = pv; l += pv; }
    l = wave_sum(l);
    float acc = 0.f;
#pragma unroll
    for (int c = 0; c < 4; ++c) {
        const int blk = (c < 3) ? selb[c] : own; const bool valid = (c == 3) || (c < nsel);
        if (valid) {
#pragma unroll
            for (int u = 0; u < 4; ++u) {
                for (int j = 0; j < 64; ++j) { const float pj = __shfl(sc[c][u], j); const int key = blk * 256 + u * 64 + j;
                    acc += pj * bf2f(a.v[(size_t)(b * SEQ + key) * 512 + 64 * h + lane]); } } }
    }
    ymix[(size_t)row * 1024 + 64 * h + lane] = (bf16_t)f2bf(acc / l);
}

__device__ __forceinline__ void gla_rec_bh(const IF1& a, float* oraw, int bh, int v) {
    const int b = bh >> 2, h = bh & 3;
    float S[64];
#pragma unroll
    for (int d = 0; d < 64; ++d) S[d] = 0.f;
    for (int t = 0; t < SEQ; ++t) {
        const size_t row = (size_t)b * SEQ + t;
        const float vv = bf2f(a.gv[row * 512 + 128 * h + v]);
        const float* ad = a.adec + row * 256 + 64 * h; const bf16_t* kp = a.gk + row * 256 + 64 * h; const bf16_t* qp = a.gq + row * 256 + 64 * h;
        float o = 0.f;
#pragma unroll
        for (int d0 = 0; d0 < 64; d0 += 8) {
#pragma unroll
            for (int d = d0; d < d0 + 8; ++d) { S[d] = ad[d] * S[d] + bf2f(kp[d]) * vv; o += bf2f(qp[d]) * S[d]; }
            asm volatile("" ::: "memory"); }
        oraw[row * 512 + 128 * h + v] = o;
    }
}

__device__ __forceinline__ void gla_norm_rh(const float* oraw, const float* g, const bf16_t* sr, bf16_t* ymix, int row, int h, int lane) {
    const float o0 = oraw[(size_t)row * 512 + 128 * h + lane], o1 = oraw[(size_t)row * 512 + 128 * h + 64 + lane];
    const float ms = wave_sum(o0 * o0 + o1 * o1) * (1.0f / 128.0f); const float rstd = 1.0f / sqrtf(ms + EPS);
    const float y0 = o0 * rstd * g[128 * h + lane] * bf2f(sr[(size_t)row * 512 + 128 * h + lane]);
    const float y1 = o1 * rstd * g[128 * h + 64 + lane] * bf2f(sr[(size_t)row * 512 + 128 * h + 64 + lane]);
    ymix[(size_t)row * 1024 + 512 + 128 * h + lane] = (bf16_t)f2bf(y0); ymix[(size_t)row * 1024 + 512 + 128 * h + 64 + lane] = (bf16_t)f2bf(y1);
}


namespace pg8 {
#define PG8_LAS __attribute__((address_space(3)))
typedef unsigned short bf16_t;
typedef short bf16x8 __attribute__((ext_vector_type(8)));
typedef float f32x4 __attribute__((ext_vector_type(4)));
typedef unsigned u32x4 __attribute__((ext_vector_type(4)));
constexpr int BM = 256, BK = 64, HALF = 128, HTB = HALF * BK * 2  , STAGE_BYTES = 8 * HTB, NXCD = 8, WGM = 8;

__host__ __device__ __forceinline__ int lds_byte(int r, int c) { const int st = (r >> 4) * 2 + (c >> 5), rr = r & 15, cc = c & 31, ob = rr * 64 + cc * 2; return st * 1024 + (ob ^ (((ob >> 9) & 1) << 5)); }
__host__ __device__ __forceinline__ void stage_rc(int b, int& R, int& C) { const int st = b / 1024, sb = b % 1024, swz = sb ^ (((sb >> 9) & 1) << 5); R = (st >> 1) * 16 + swz / 64; C = (st & 1) * 32 + (swz % 64) / 2; }
__host__ __device__ __forceinline__ int perm32(int rho) { const int n = rho >> 4, i = rho & 15; return 8 * (i >> 2) + 4 * n + (i & 3); }

struct Unit { int pm, pn; };
struct Gemm { const bf16_t* A; const bf16_t* Bt; int M, N, K; };

struct StaticOrder {
    int nM, nN, nwg, G, c;
    __host__ __device__ void init(int nM_, int nN_, int G_, int c_) { nM = nM_; nN = nN_; nwg = nM * nN; G = G_; c = c_; }
    __host__ __device__ bool next(int i, Unit& u) const {
        const long L = (long)i * G + c; if (L >= nwg) return false;
        int wgid = (int)L; { const int q = nwg / NXCD, r = nwg % NXCD, xcd = wgid % NXCD, off = wgid / NXCD; wgid = (xcd < r ? xcd * (q + 1) : r * (q + 1) + (xcd - r) * q) + off; }
        const int nig = WGM * nN, gid = wgid / nig, fm = gid * WGM, gsz = (nM - fm) < WGM ? (nM - fm) : WGM;
        u.pm = fm + ((wgid % nig) % gsz); u.pn = (wgid % nig) / gsz; return true;
    }
    __device__ __forceinline__ void a_ready(const Unit&) const {}
    __device__ __forceinline__ void done(const Unit&) const {}
};

struct AMapStd { static constexpr int HALF_ROWS = 128; static __device__ __forceinline__ int rowmap(int R) { return R; } static __device__ __forceinline__ int tile_row(int pm) { return pm * 256; } };
struct AMapConv { static constexpr int HALF_ROWS = 64; static __device__ __forceinline__ int rowmap(int R) { return 126 * (R >> 6) + (R & 63); }
    static __device__ __forceinline__ int tile_row(int pm) { return (pm / 33) * SEQ + 252 * (pm % 33) - 2; } };

__device__ __forceinline__ unsigned cvt_pk_bf16(float lo, float hi) { unsigned r; asm volatile("v_cvt_pk_bf16_f32 %0, %1, %2" : "=v"(r) : "v"(lo), "v"(hi)); return r; }
__device__ __forceinline__ u32x4 pack8(const f32x4 a, const f32x4 b) { u32x4 w; w.x = cvt_pk_bf16(a[0], a[1]); w.y = cvt_pk_bf16(a[2], a[3]); w.z = cvt_pk_bf16(b[0], b[1]); w.w = cvt_pk_bf16(b[2], b[3]); return w; }
__device__ __forceinline__ float silu_f(float r) { return r * __builtin_amdgcn_rcpf(1.0f + __expf(-r)); }

struct EpiInProj {
    static constexpr bool PERM = true, AFTER_DRAIN = false;
    bf16_t *q, *k, *v, *gq, *gk, *gv, *sr; float *loga, *kmean; const float* rope; const float* b_gate;
    template <bool ISQ> __device__ __forceinline__ void rope_tile(const f32x4 (&acc)[2][2][4][2], const Unit& u, int row0, int cw, int fr) const {
        bf16_t* dst = ISQ ? q : k; const int colt = (u.pn & 1) * 256; const float sc = ISQ ? C2 : 1.0f;
        float ks[2][8];
#pragma unroll
        for (int bj = 0; bj < 2; ++bj)
#pragma unroll
            for (int e = 0; e < 8; ++e) ks[bj][e] = 0.f;
#pragma unroll
        for (int ai = 0; ai < 2; ++ai)
#pragma unroll
            for (int m = 0; m < 4; ++m) { const int row = row0 + ai * HALF + m * 16; const int t = row & (SEQ - 1);
#pragma unroll
                for (int bj = 0; bj < 2; ++bj) { const int col = colt + bj * HALF + cw; const int i0 = (col & 63) >> 1;
                    const float* rp = rope + (size_t)(t * 32 + i0) * 2; const f32x4 c0 = *(const f32x4*)rp, c1 = *(const f32x4*)(rp + 4);
                    const f32x4 a = acc[ai][bj][m][0], b = acc[ai][bj][m][1]; float o[8];
                    o[0] = a[0] * c0[0] - a[1] * c0[1]; o[1] = a[1] * c0[0] + a[0] * c0[1];
                    o[2] = a[2] * c0[2] - a[3] * c0[3]; o[3] = a[3] * c0[2] + a[2] * c0[3];
                    o[4] = b[0] * c1[0] - b[1] * c1[1]; o[5] = b[1] * c1[0] + b[0] * c1[1];
                    o[6] = b[2] * c1[2] - b[3] * c1[3]; o[7] = b[3] * c1[2] + b[2] * c1[3];
                    if (!ISQ) {
#pragma unroll
                        for (int e = 0; e < 8; ++e) ks[bj][e] += o[e]; }
                    u32x4 w; w.x = cvt_pk_bf16(o[0] * sc, o[1] * sc); w.y = cvt_pk_bf16(o[2] * sc, o[3] * sc); w.z = cvt_pk_bf16(o[4] * sc, o[5] * sc); w.w = cvt_pk_bf16(o[6] * sc, o[7] * sc);
                    *(u32x4*)(dst + (size_t)row * 512 + col) = w; }
                if (!ISQ) {
#pragma unroll
                    for (int bj = 0; bj < 2; ++bj)
#pragma unroll
                        for (int e = 0; e < 8; ++e) asm volatile("" : "+v"(ks[bj][e])); }
                asm volatile("" ::: "memory"); __builtin_amdgcn_sched_barrier(0); }
        if (!ISQ) {
#pragma unroll
            for (int bj = 0; bj < 2; ++bj)
#pragma unroll
                for (int e = 0; e < 8; ++e) { float s = ks[bj][e]; s += __shfl_xor(s, 1); s += __shfl_xor(s, 2); s += __shfl_xor(s, 4); s += __shfl_xor(s, 8);
                    if (fr == 0) __hip_atomic_fetch_add(kmean + (size_t)u.pm * 512 + colt + bj * HALF + cw + e, s * (1.0f / 256.0f), __ATOMIC_RELAXED, __HIP_MEMORY_SCOPE_AGENT); }
        }
    }
    __device__ __forceinline__ void operator()(const f32x4 (&acc)[2][2][4][2], const Unit& u, int wr, int wc, int fr, int fq) const {
        const int pn = u.pn; const int row0 = u.pm * BM + wr * 64 + fr; const int cw = wc * 32 + 8 * fq;
        if (pn < 2) { rope_tile<true>(acc, u, row0, cw, fr); return; }
        if (pn < 4) { rope_tile<false>(acc, u, row0, cw, fr); return; }
        if (pn == 12) {
            f32x4 bv[2][2];
#pragma unroll
            for (int bj = 0; bj < 2; ++bj)
#pragma unroll
                for (int n = 0; n < 2; ++n) bv[bj][n] = *(const f32x4*)(b_gate + bj * HALF + cw + 4 * n);
#pragma unroll
            for (int ai = 0; ai < 2; ++ai)
#pragma unroll
                for (int m = 0; m < 4; ++m) { const int row = row0 + ai * HALF + m * 16;
#pragma unroll
                    for (int bj = 0; bj < 2; ++bj)
#pragma unroll
                        for (int n = 0; n < 2; ++n) { const f32x4 z = acc[ai][bj][m][n] + bv[bj][n]; f32x4 la;
#pragma unroll
                            for (int e = 0; e < 4; ++e) la[e] = (fminf(z[e], 0.f) - __logf(1.0f + __expf(-fabsf(z[e])))) * (1.0f / 16.0f);
                            *(f32x4*)(loga + (size_t)row * 256 + bj * HALF + cw + 4 * n) = la; } }
            return;
        }
        bf16_t* dst; int ld, colt, mode;
        if (pn < 6) { dst = v; ld = 512; colt = (pn - 4) * 256; mode = 0; }
        else if (pn == 6) { dst = gq; ld = 256; colt = 0; mode = 1; }
        else if (pn == 7) { dst = gk; ld = 256; colt = 0; mode = 0; }
        else if (pn < 10) { dst = gv; ld = 512; colt = (pn - 8) * 256; mode = 0; }
        else { dst = sr; ld = 512; colt = (pn - 10) * 256; mode = 2; }
        const float sc = (mode == 1) ? 0.125f : 1.0f;
#pragma unroll
        for (int ai = 0; ai < 2; ++ai)
#pragma unroll
            for (int m = 0; m < 4; ++m) { bf16_t* rowp = dst + (size_t)(row0 + ai * HALF + m * 16) * ld + colt + cw;
#pragma unroll
                for (int bj = 0; bj < 2; ++bj) { f32x4 a = acc[ai][bj][m][0], b = acc[ai][bj][m][1];
                    if (mode == 2) {
#pragma unroll
                        for (int e = 0; e < 4; ++e) { a[e] = silu_f(a[e]); b[e] = silu_f(b[e]); } }
                    else { a = a * sc; b = b * sc; }
                    *(u32x4*)(rowp + bj * HALF) = pack8(a, b); } }
    }
};

struct EpiOutProj {
    static constexpr bool PERM = true, AFTER_DRAIN = false;
    const float* x; float* h; bf16_t* hs; const float* g; float* ssq;
    __device__ __forceinline__ void operator()(const f32x4 (&acc)[2][2][4][2], const Unit& u, int wr, int wc, int fr, int fq) const {
        const int row0 = u.pm * BM + wr * 64 + fr; const int col0 = u.pn * BM + wc * 32 + 8 * fq;
        f32x4 gv[2][2];
#pragma unroll
        for (int bj = 0; bj < 2; ++bj)
#pragma unroll
            for (int n = 0; n < 2; ++n) gv[bj][n] = *(const f32x4*)(g + col0 + bj * HALF + 4 * n);
#pragma unroll
        for (int ai = 0; ai < 2; ++ai)
#pragma unroll
            for (int m = 0; m < 4; ++m) { const int row = row0 + ai * HALF + m * 16; const size_t off = (size_t)row * DM + col0; float ss = 0.f;
#pragma unroll
                for (int bj = 0; bj < 2; ++bj) { const f32x4 xa = *(const f32x4*)(x + off + bj * HALF), xb = *(const f32x4*)(x + off + bj * HALF + 4);
                    const f32x4 ha = xa + acc[ai][bj][m][0], hb = xb + acc[ai][bj][m][1];
                    *(f32x4*)(h + off + bj * HALF) = ha; *(f32x4*)(h + off + bj * HALF + 4) = hb;
                    ss += (ha[0] * ha[0] + ha[1] * ha[1]) + (ha[2] * ha[2] + ha[3] * ha[3]) + (hb[0] * hb[0] + hb[1] * hb[1]) + (hb[2] * hb[2] + hb[3] * hb[3]);
                    *(u32x4*)(hs + off + bj * HALF) = pack8(ha * gv[bj][0], hb * gv[bj][1]); }
                ss += __shfl_xor(ss, 16); ss += __shfl_xor(ss, 32);
                if (fq == 0) ssq[(size_t)row * 16 + u.pn * 4 + wc] = ss; }
    }
};
struct EpiDown {
    static constexpr bool PERM = true, AFTER_DRAIN = false;
    float* y; float* ssq;
    __device__ __forceinline__ void operator()(const f32x4 (&acc)[2][2][4][2], const Unit& u, int wr, int wc, int fr, int fq) const {
        const int row0 = u.pm * BM + wr * 64 + fr; const int col0 = u.pn * BM + wc * 32 + 8 * fq;
#pragma unroll
        for (int ai = 0; ai < 2; ++ai)
#pragma unroll
            for (int m = 0; m < 4; ++m) { const int row = row0 + ai * HALF + m * 16; const size_t off = (size_t)row * DM + col0; float ss = 0.f;
#pragma unroll
                for (int bj = 0; bj < 2; ++bj) { const f32x4 xa = *(const f32x4*)(y + off + bj * HALF), xb = *(const f32x4*)(y + off + bj * HALF + 4);
                    const f32x4 ha = xa + acc[ai][bj][m][0], hb = xb + acc[ai][bj][m][1];
                    *(f32x4*)(y + off + bj * HALF) = ha; *(f32x4*)(y + off + bj * HALF + 4) = hb;
                    ss += (ha[0] * ha[0] + ha[1] * ha[1]) + (ha[2] * ha[2] + ha[3] * ha[3]) + (hb[0] * hb[0] + hb[1] * hb[1]) + (hb[2] * hb[2] + hb[3] * hb[3]); }
                ss += __shfl_xor(ss, 16); ss += __shfl_xor(ss, 32);
                if (fq == 0) ssq[(size_t)row * 16 + u.pn * 4 + wc] = ss; }
    }
};
struct EpiUp {
    static constexpr bool PERM = true, AFTER_DRAIN = false;
    const float* ssq; const float* cw; const float* cb; bf16_t* act;
    __device__ __forceinline__ void operator()(const f32x4 (&acc)[2][2][4][2], const Unit& u, int wr, int wc, int fr, int fq) const {
        const int b = u.pm / 33, j = u.pm % 33; const int tb = 252 * j - 2 + 126 * wr;
        const int ch0 = u.pn * 128 + wc * 32 + 8 * fq;
        float rs[8];
#pragma unroll
        for (int g8 = 0; g8 < 8; ++g8) { int row = b * SEQ + tb + 16 * g8 + fr; row = row < 0 ? 0 : (row > M - 1 ? M - 1 : row);
            const f32x4* sp = (const f32x4*)(ssq + (size_t)row * 16); const f32x4 s0 = sp[0], s1 = sp[1], s2 = sp[2], s3 = sp[3];
            const float s = ((s0[0] + s0[1]) + (s0[2] + s0[3])) + ((s1[0] + s1[1]) + (s1[2] + s1[3])) + ((s2[0] + s2[1]) + (s2[2] + s2[3])) + ((s3[0] + s3[1]) + (s3[2] + s3[3]));
            rs[g8] = __builtin_amdgcn_rsqf(s * (1.0f / DM) + EPS);
            asm volatile("" : "+v"(rs[g8]) :: "memory"); __builtin_amdgcn_sched_barrier(0); }
        const int lane = fq * 16 + fr; const int src1 = ((lane & 48) | ((fr + 15) & 15)) * 4, src2 = ((lane & 48) | ((fr + 14) & 15)) * 4;
        const bool last1 = (fr == 15), last2 = (fr >= 14);
#pragma unroll
        for (int n = 0; n < 2; ++n) {
            const int ch = ch0 + 4 * n;
            const f32x4 wg0 = *(const f32x4*)(cw + ch), wg1 = *(const f32x4*)(cw + NUP + ch), wg2 = *(const f32x4*)(cw + 2 * NUP + ch), bg = *(const f32x4*)(cb + ch);
            const f32x4 wv0 = *(const f32x4*)(cw + DFF + ch), wv1 = *(const f32x4*)(cw + NUP + DFF + ch), wv2 = *(const f32x4*)(cw + 2 * NUP + DFF + ch), bvv = *(const f32x4*)(cb + DFF + ch);
            f32x4 pg = {0.f, 0.f, 0.f, 0.f}, pv = {0.f, 0.f, 0.f, 0.f};
#pragma unroll
            for (int g8 = 0; g8 < 8; ++g8) { const int ai = g8 >> 2, m = g8 & 3; const int qi = 16 * g8 + fr; const int t = tb + qi; const bool t1ok = t >= 1, t2ok = t >= 2;
                const f32x4 cg = acc[ai][0][m][n] * rs[g8], cv = acc[ai][1][m][n] * rs[g8]; f32x4 o;
#pragma unroll
                for (int e = 0; e < 4; ++e) {
                    float g1 = __builtin_bit_cast(float, __builtin_amdgcn_ds_bpermute(src1, __builtin_bit_cast(int, last1 ? pg[e] : cg[e])));
                    float g2 = __builtin_bit_cast(float, __builtin_amdgcn_ds_bpermute(src2, __builtin_bit_cast(int, last2 ? pg[e] : cg[e])));
                    g1 = t1ok ? g1 : 0.f; g2 = t2ok ? g2 : 0.f;
                    const float gate = silu_f(bg[e] + wg2[e] * cg[e] + wg1[e] * g1 + wg0[e] * g2);
                    float v1 = __builtin_bit_cast(float, __builtin_amdgcn_ds_bpermute(src1, __builtin_bit_cast(int, last1 ? pv[e] : cv[e])));
                    float v2 = __builtin_bit_cast(float, __builtin_amdgcn_ds_bpermute(src2, __builtin_bit_cast(int, last2 ? pv[e] : cv[e])));
                    v1 = t1ok ? v1 : 0.f; v2 = t2ok ? v2 : 0.f;
                    o[e] = gate * (bvv[e] + wv2[e] * cv[e] + wv1[e] * v1 + wv0[e] * v2); }
                if (qi >= 2 && t < SEQ) { typedef unsigned u32x2v __attribute__((ext_vector_type(2))); u32x2v w; w.x = cvt_pk_bf16(o[0], o[1]); w.y = cvt_pk_bf16(o[2], o[3]);
                    *(u32x2v*)(act + (size_t)(b * SEQ + t) * DFF + ch) = w; }
                pg = cg; pv = cv; __builtin_amdgcn_sched_barrier(0); }
        }
    }
};
template <class Epi, class Sched, class AMap, bool ALIGN_EPI = false, bool SP2 = false>
__device__ __forceinline__ void gemm_phase(PG8_LAS unsigned char* lds, const Gemm g, const Sched& S, const Epi& E) {
    const int tid = threadIdx.x, wid = __builtin_amdgcn_readfirstlane(tid >> 6), lane = tid & 63, wr = wid >> 2, wc = wid & 3, fr = lane & 15, fq = lane >> 4;
    const int K = g.K, nt = K / BK;
    unsigned voffA[2], voffB[2];
#pragma unroll
    for (int i = 0; i < 2; ++i) { int R, C; stage_rc(tid * 16 + i * 8192, R, C); const int Rb = Epi::PERM ? ((R & ~31) + perm32(R & 31)) : R;
        voffA[i] = (unsigned)(AMap::rowmap(R) * K + C) * 2u; voffB[i] = (unsigned)(Rb * K + C) * 2u; }
    const size_t kstep = (size_t)(BK * 2);
    const size_t hstepA = (size_t)AMap::HALF_ROWS * K * 2, hstepB = (size_t)HALF * K * 2;
    const size_t tstepB = 2 * hstepB;
    const unsigned ldsw = (unsigned)wid * 1024u;
    const int aoff = lds_byte(wr * 64 + fr, fq * 8), boff = lds_byte(wc * 32 + fr, fq * 8);
#define PG8_SA(b, h) (((b) * 2 + (h)) * HTB)
#define PG8_SB(b, h) ((4 + (b) * 2 + (h)) * HTB)
#define PG8_STAGE(bufoff, gbase, voff) do { _Pragma("unroll") for (int _i = 0; _i < 2; ++_i) \
        __builtin_amdgcn_global_load_lds((const unsigned*)((const char*)(gbase) + (voff)[_i]), (PG8_LAS unsigned*)(lds + (bufoff) + ldsw + _i * 8192), 16, 0, 0); } while (0)
#define PG8_LDA(dst, b, h) do { _Pragma("unroll") for (int m = 0; m < 4; ++m) _Pragma("unroll") for (int k = 0; k < 2; ++k) dst[m][k] = *(const PG8_LAS bf16x8*)(lds + PG8_SA(b, h) + aoff + m * 2048 + k * 1024); } while (0)
#define PG8_LDB(dst, b, h) do { _Pragma("unroll") for (int n = 0; n < 2; ++n) _Pragma("unroll") for (int k = 0; k < 2; ++k) dst[n][k] = *(const PG8_LAS bf16x8*)(lds + PG8_SB(b, h) + boff + n * 2048 + k * 1024); } while (0)
#define PG8_MMA(ai, bj, At, Bt) do { __builtin_amdgcn_s_setprio(1); _Pragma("unroll") for (int m = 0; m < 4; ++m) _Pragma("unroll") for (int n = 0; n < 2; ++n) _Pragma("unroll") for (int k = 0; k < 2; ++k) \
        acc[ai][bj][m][n] = __builtin_amdgcn_mfma_f32_16x16x32_bf16(Bt[n][k], At[m][k], acc[ai][bj][m][n], 0, 0, 0); __builtin_amdgcn_s_setprio(0); } while (0)
#define PG8_WAIT_V(n) asm volatile("s_waitcnt vmcnt(" #n ")" ::: "memory")
#define PG8_WAIT_L(n) asm volatile("s_waitcnt lgkmcnt(" #n ")" ::: "memory")
#define PG8_BAR __builtin_amdgcn_s_barrier()
#define PG8_SCHED __builtin_amdgcn_sched_barrier(0)
    Unit cur, nxt; int ui = 0;
    if (!S.next(0, cur)) return;
    f32x4 acc[2][2][4][2];
#pragma unroll
    for (int a = 0; a < 2; ++a)
#pragma unroll
        for (int b = 0; b < 2; ++b)
#pragma unroll
            for (int m = 0; m < 4; ++m)
#pragma unroll
                for (int n = 0; n < 2; ++n) acc[a][b][m][n] = (f32x4){0.f, 0.f, 0.f, 0.f};
    bf16x8 At[4][2], B0[2][2], B1[2][2];
    const char* cA = (const char*)g.A + (long)AMap::tile_row(cur.pm) * K * 2; const char* cB = (const char*)g.Bt + (size_t)cur.pn * tstepB;
    S.a_ready(cur);
    if constexpr (SP2) {
        PG8_STAGE(PG8_SB(0, 0), cB, voffB); PG8_STAGE(PG8_SB(0, 1), cB + hstepB, voffB); PG8_STAGE(PG8_SA(0, 0), cA, voffA); PG8_STAGE(PG8_SA(0, 1), cA + hstepA, voffA);
        if (wr == 1) PG8_BAR;
        PG8_WAIT_V(2); PG8_BAR;
        PG8_STAGE(PG8_SB(1, 0), cB + kstep, voffB); PG8_STAGE(PG8_SA(1, 0), cA + kstep, voffA); PG8_STAGE(PG8_SB(1, 1), cB + hstepB + kstep, voffB);
        PG8_WAIT_V(6); PG8_BAR;
    } else {
        PG8_STAGE(PG8_SB(0, 0), cB, voffB); PG8_STAGE(PG8_SA(0, 0), cA, voffA); PG8_STAGE(PG8_SB(0, 1), cB + hstepB, voffB); PG8_STAGE(PG8_SA(0, 1), cA + hstepA, voffA);
        if (wr == 1) PG8_BAR;
        PG8_WAIT_V(4); PG8_BAR;
        PG8_STAGE(PG8_SB(1, 0), cB + kstep, voffB); PG8_STAGE(PG8_SA(1, 0), cA + kstep, voffA); PG8_STAGE(PG8_SB(1, 1), cB + hstepB + kstep, voffB);
        PG8_WAIT_V(6); PG8_BAR;
    }
    for (;;) {
        const bool has_next = S.next(ui + 1, nxt);
        const char* nA = has_next ? (const char*)g.A + (long)AMap::tile_row(nxt.pm) * K * 2 : cA; const char* nB = has_next ? (const char*)g.Bt + (size_t)nxt.pn * tstepB : cB;
        for (int t = 0; t < nt; t += 2) {
            const bool last = (t == nt - 2);
            const char* a1 = cA + (size_t)(t + 1) * kstep;
            const char* a2 = last ? nA : cA + (size_t)(t + 2) * kstep; const char* b2 = last ? nB : cB + (size_t)(t + 2) * kstep;
            const char* a3 = a2 + kstep; const char* b3 = b2 + kstep;
            if (last && has_next) S.a_ready(nxt);
            if constexpr (SP2) {
            PG8_LDB(B0, 0, 0); PG8_LDB(B1, 0, 1); PG8_SCHED; PG8_LDA(At, 0, 0); PG8_STAGE(PG8_SA(1, 1), a1 + hstepA, voffA);
            PG8_WAIT_V(8); PG8_WAIT_L(0); PG8_BAR; PG8_MMA(0, 0, At, B0); PG8_MMA(0, 1, At, B1); PG8_BAR; PG8_SCHED;
            PG8_LDA(At, 0, 1); PG8_STAGE(PG8_SB(0, 0), b2, voffB); PG8_STAGE(PG8_SB(0, 1), b2 + hstepB, voffB); PG8_STAGE(PG8_SA(0, 0), a2, voffA);
            PG8_WAIT_V(8); PG8_WAIT_L(0); PG8_BAR; PG8_MMA(1, 0, At, B0); PG8_MMA(1, 1, At, B1); PG8_BAR; PG8_SCHED;
            PG8_LDB(B0, 1, 0); PG8_LDB(B1, 1, 1); PG8_SCHED; PG8_LDA(At, 1, 0); PG8_STAGE(PG8_SA(0, 1), a2 + hstepA, voffA);
            PG8_WAIT_V(8); PG8_WAIT_L(0); PG8_BAR; PG8_MMA(0, 0, At, B0); PG8_MMA(0, 1, At, B1); PG8_BAR; PG8_SCHED;
            PG8_LDA(At, 1, 1); PG8_STAGE(PG8_SB(1, 0), b3, voffB); PG8_STAGE(PG8_SB(1, 1), b3 + hstepB, voffB); PG8_STAGE(PG8_SA(1, 0), a3, voffA);
            PG8_WAIT_V(8); PG8_WAIT_L(0); PG8_BAR; PG8_MMA(1, 0, At, B0); PG8_MMA(1, 1, At, B1); PG8_BAR; PG8_SCHED;
            } else {
            PG8_LDB(B0, 0, 0); PG8_SCHED; PG8_LDA(At, 0, 0); PG8_STAGE(PG8_SA(1, 1), a1 + hstepA, voffA);
            PG8_WAIT_L(8); PG8_BAR; PG8_WAIT_L(0); PG8_MMA(0, 0, At, B0); PG8_BAR; PG8_SCHED;
            PG8_LDB(B1, 0, 1); PG8_STAGE(PG8_SB(0, 0), b2, voffB);
            PG8_BAR; PG8_WAIT_L(0); PG8_MMA(0, 1, At, B1); PG8_BAR;
            PG8_LDA(At, 0, 1); PG8_STAGE(PG8_SA(0, 0), a2, voffA);
            PG8_BAR; PG8_WAIT_L(0); PG8_MMA(1, 0, At, B0); PG8_BAR; PG8_SCHED;
            PG8_STAGE(PG8_SB(0, 1), b2 + hstepB, voffB);
            PG8_WAIT_V(6); PG8_BAR; PG8_MMA(1, 1, At, B1); PG8_BAR;
            PG8_LDB(B0, 1, 0); PG8_SCHED; PG8_LDA(At, 1, 0); PG8_STAGE(PG8_SA(0, 1), a2 + hstepA, voffA);
            PG8_WAIT_L(8); PG8_BAR; PG8_WAIT_L(0); PG8_MMA(0, 0, At, B0); PG8_BAR; PG8_SCHED;
            PG8_LDB(B1, 1, 1); PG8_STAGE(PG8_SB(1, 0), b3, voffB);
            PG8_BAR; PG8_WAIT_L(0); PG8_MMA(0, 1, At, B1); PG8_BAR;
            PG8_LDA(At, 1, 1); PG8_STAGE(PG8_SA(1, 0), a3, voffA);
            PG8_BAR; PG8_WAIT_L(0); PG8_MMA(1, 0, At, B0); PG8_BAR; PG8_SCHED;
            PG8_STAGE(PG8_SB(1, 1), b3 + hstepB, voffB);
            PG8_WAIT_V(6); PG8_BAR; PG8_MMA(1, 1, At, B1); PG8_BAR;
            }
        }
        if constexpr (ALIGN_EPI) { if (wr == 0) PG8_BAR; }
        if constexpr (!Epi::AFTER_DRAIN) { E(acc, cur, wr, wc, fr, fq); S.done(cur); }
        if (!has_next) break;
#pragma unroll
        for (int a = 0; a < 2; ++a)
#pragma unroll
            for (int b = 0; b < 2; ++b)
#pragma unroll
                for (int m = 0; m < 4; ++m)
#pragma unroll
                    for (int n = 0; n < 2; ++n) acc[a][b][m][n] = (f32x4){0.f, 0.f, 0.f, 0.f};
        cur = nxt; cA = nA; cB = nB; ++ui;
        if constexpr (ALIGN_EPI) { if (wr == 1) PG8_BAR; }
    }
    PG8_WAIT_V(0);
    if constexpr (!ALIGN_EPI) { if (wr == 0) PG8_BAR; }
    PG8_BAR;
    if constexpr (Epi::AFTER_DRAIN) { E.fused(acc, cur, wr, wc, fr, fq, lds, wid, lane); S.done(cur); }
#undef PG8_SA
#undef PG8_SB
#undef PG8_STAGE
#undef PG8_LDA
#undef PG8_LDB
#undef PG8_MMA
#undef PG8_WAIT_V
#undef PG8_WAIT_L
#undef PG8_BAR
#undef PG8_SCHED
}
}

constexpr int NWAVES = 8;
constexpr size_t MiB = 1u << 20;
constexpr size_t WS_CTL = 0, CTL_ZERO_BYTES = 1 * MiB;
constexpr size_t WS_WIN = 2 * MiB, WS_WOUT = 9 * MiB, WS_WUP = 11 * MiB, WS_WDOWN = 22 * MiB;
constexpr size_t WS_ROPE = 28 * MiB, WS_KMEAN = 30 * MiB, WS_SSQA = 31 * MiB, WS_SSQB = 32 * MiB;
constexpr size_t WS_XN = 34 * MiB + 65536;
constexpr size_t WS_Q = 68 * MiB, WS_K = 84 * MiB, WS_V = 100 * MiB, WS_GQ = 116 * MiB, WS_GK = 124 * MiB, WS_GV = 132 * MiB, WS_SR = 148 * MiB, WS_LOGA = 164 * MiB, WS_ADEC = 180 * MiB;
constexpr size_t WS_YMIX = 196 * MiB;
constexpr size_t WS_ACT = 68 * MiB;
constexpr size_t WS_END = 256 * MiB;
constexpr int CW_BAR = 4096;

constexpr int RING_OFF = 0, RING_BYTES = 131072;
constexpr int LDSCTL_OFF = RING_BYTES, MISC_OFF = LDSCTL_OFF + 320;
constexpr int LDS_BYTES = 147456;

#define GAS __attribute__((address_space(1)))
#define LAS __attribute__((address_space(3)))
typedef unsigned v4u __attribute__((ext_vector_type(4)));
typedef float f32x4 __attribute__((ext_vector_type(4)));
typedef GAS unsigned gu32;
#define RLX_AGENT __ATOMIC_RELAXED, __HIP_MEMORY_SCOPE_AGENT
#define LDS_WAIT() asm volatile("s_waitcnt lgkmcnt(0)" ::: "memory")
#define VM_WAIT() asm volatile("s_waitcnt vmcnt(0)" ::: "memory")
__device__ __forceinline__ unsigned pk2(float lo, float hi) { return f2bf(lo) | (f2bf(hi) << 16); }
#define XB_TMO      128
#define XB_XCNT(j)  (256  + 64 * (j))
#define XB_XSUB(j)  (1280 + 64 * (j))
#define XB_XGEN(j)  (2304 + 64 * (j))
#define XB_TOP      3328
#define XB_TOPGEN   3392
#define XCD_BAR_WORDS 3456
#define XB_SPIN_CAP (1u << 18)

__device__ __forceinline__ unsigned xb_ld(unsigned* p)              { return __hip_atomic_load(p, __ATOMIC_RELAXED, __HIP_MEMORY_SCOPE_AGENT); }
__device__ __forceinline__ unsigned xb_add(unsigned* p, unsigned v) { return __hip_atomic_fetch_add(p, v, __ATOMIC_RELAXED, __HIP_MEMORY_SCOPE_AGENT); }
__device__ __forceinline__ unsigned xb_xcc_id() { return (unsigned)__builtin_amdgcn_s_getreg((3 << 11) | 20) & 0xFu; }
#define XB_SPIN(cond, bar) do { unsigned _sp = 0; while (cond) { __builtin_amdgcn_s_sleep(1); \
    if ((++_sp & 255u) == 0u) { if (xb_ld(&(bar)[XB_TMO])) break; if (_sp > XB_SPIN_CAP) { atomicAdd(&(bar)[XB_TMO], 1u); break; } } } } while (0)

struct XcdBarrier {
    unsigned* bar; unsigned x;
    volatile LAS unsigned* st;
};

__device__ __forceinline__ XcdBarrier xcd_barrier_post(unsigned* bar, volatile LAS unsigned* st) {
    XcdBarrier b; b.bar = bar; b.x = xb_xcc_id(); b.st = st;
    if (threadIdx.x == 0) (void)xb_add(&bar[XB_XCNT(b.x)], 1u);
    return b;
}
__device__ __forceinline__ void xcd_barrier_complete(unsigned* bar, unsigned x, unsigned& nloc, unsigned& nx) {
    const unsigned G = gridDim.x * gridDim.y * gridDim.z;
    unsigned sum, cnt, mine, sp = 0u;
    for (;;) {
        sum = 0u; cnt = 0u; mine = 0u;
#pragma unroll
        for (unsigned j = 0; j < 16; ++j) { const unsigned c = xb_ld(&bar[XB_XCNT(j)]); sum += c; cnt += (c > 0u) ? 1u : 0u; mine = (j == x) ? c : mine; }
        if (sum == G) break;
        __builtin_amdgcn_s_sleep(1);
        if ((++sp & 255u) == 0u) { if (xb_ld(&bar[XB_TMO])) break; if (sp > XB_SPIN_CAP) { atomicAdd(&bar[XB_TMO], 1u); break; } }
    }
    nloc = mine > 0u ? mine : 1u; nx = cnt > 0u ? cnt : 1u;
}

__device__ __forceinline__ void xcd_barrier(const XcdBarrier& b) {
    asm volatile("s_waitcnt vmcnt(0)" ::: "memory");
    __syncthreads();
    if (threadIdx.x == 0) {
        unsigned* bar = b.bar;
        __builtin_amdgcn_s_waitcnt(0);
        unsigned nloc = b.st[0], nx = b.st[1];
        if (nloc == 0u) { xcd_barrier_complete(bar, b.x, nloc, nx); b.st[0] = nloc; b.st[1] = nx; }
        const unsigned old = xb_add(&bar[XB_XSUB(b.x)], 1u);
        const unsigned gen = old / nloc;
        if (old + 1u == (gen + 1u) * nloc) {
            __builtin_amdgcn_fence(__ATOMIC_RELEASE, "agent");
            asm volatile("s_waitcnt vmcnt(0)" ::: "memory");
            const unsigned og = xb_add(&bar[XB_TOP], 1u);
            const unsigned tg = og / nx;
            if (og + 1u == (tg + 1u) * nx) xb_add(&bar[XB_TOPGEN], 1u);
            else XB_SPIN(xb_ld(&bar[XB_TOPGEN]) == tg, bar);
            __builtin_amdgcn_fence(__ATOMIC_ACQUIRE, "agent");
            xb_add(&bar[XB_XGEN(b.x)], 1u);
            asm volatile("s_waitcnt vmcnt(0)" ::: "memory");
        } else {
            XB_SPIN(xb_ld(&bar[XB_XGEN(b.x)]) == gen, bar);
            __builtin_amdgcn_fence(__ATOMIC_ACQUIRE, "agent");
            asm volatile("s_waitcnt vmcnt(0)" ::: "memory");
        }
    }
    __syncthreads();
}

struct Frame {
    LAS unsigned char* lds; volatile LAS unsigned* MISC; gu32* ctl;
    int tid, lane, wave, vcu, G;
};
template <int CMAP> __device__ __forceinline__ int col_map(int n) {
    if (CMAP == 1) { return (n < 1024) ? ((n & ~63) + ((n & 1) << 5) + ((n & 63) >> 1)) : n; }
    if (CMAP == 2) { const int pn = n >> 8, jj = n & 255; return (jj < 128) ? (pn * 128 + jj) : (DFF + pn * 128 + (jj - 128)); }
    return n;
}
template <int CMAP> __device__ __forceinline__ void p0_transpose_item(const float* W, int K, int ldw, int Nout, bf16_t* WT, LAS float* scr, int item, int lane) {
    const int nblk = Nout / 32, kb = item / nblk, nb = item % nblk, k0 = 64 * kb, n0 = 32 * nb;
    const int sc = col_map<CMAP>(n0 + (lane & 31));
#pragma unroll 8
    for (int i = 0; i < 32; ++i) { const int kk = 2 * i + (lane >> 5); scr[kk * 33 + (lane & 31)] = W[(size_t)(k0 + kk) * ldw + sc]; }
    LDS_WAIT(); asm volatile("" ::: "memory");
    const int c = lane & 7;
#pragma unroll
    for (int j = 0; j < 4; ++j) { const int n = (lane >> 3) + 8 * j; const LAS float* s = scr + (8 * c) * 33 + n;
        v4u o; o.x = pk2(s[0 * 33], s[1 * 33]); o.y = pk2(s[2 * 33], s[3 * 33]); o.z = pk2(s[4 * 33], s[5 * 33]); o.w = pk2(s[6 * 33], s[7 * 33]);
        *(GAS v4u*)(WT + (size_t)(n0 + n) * K + k0 + 8 * c) = o; }
    LDS_WAIT(); asm volatile("" ::: "memory");
}

struct Args { const float* in[13]; float* out; unsigned char* ws; int ph_lo, ph_hi, li, pad; };

__device__ __forceinline__ void p0_prologue(Frame& F, const Args& a) {
    unsigned char* ws = a.ws;
    LAS float* scr = (LAS float*)(F.lds + RING_OFF + F.wave * 16384);
    const int gw = F.vcu * NWAVES + F.wave, NGW = F.G * NWAVES;
    const float* w_in = a.in[2]; const float* w_gate_up = a.in[3]; const float* w_out = a.in[6]; const float* w_up = a.in[8]; const float* w_down = a.in[11];
    bf16_t* WIN = (bf16_t*)(ws + WS_WIN); bf16_t* WOUT = (bf16_t*)(ws + WS_WOUT); bf16_t* WUP = (bf16_t*)(ws + WS_WUP); bf16_t* WDOWN = (bf16_t*)(ws + WS_WDOWN);
    constexpr int I_IN = (DM / 64) * (3072 / 32), I_OUT = (DM / 64) * (DM / 32), I_UP = (DM / 64) * (NUP / 32), I_DOWN = (DFF / 64) * (DM / 32);
    constexpr int NITEMS = I_IN + I_OUT + I_UP + I_DOWN;
    for (int it = gw; it < NITEMS; it += NGW) {
        int r = it;
        if (r < I_IN) { p0_transpose_item<1>(w_in, DM, NIN, 3072, WIN, scr, r, F.lane); continue; } r -= I_IN;
        if (r < I_OUT) { p0_transpose_item<0>(w_out, DM, DM, DM, WOUT, scr, r, F.lane); continue; } r -= I_OUT;
        if (r < I_UP) { p0_transpose_item<2>(w_up, DM, NUP, NUP, WUP, scr, r, F.lane); continue; } r -= I_UP;
        p0_transpose_item<0>(w_down, DFF, DM, DM, WDOWN, scr, r, F.lane);
    }
    const int gt = gw * 64 + F.lane, NGT = NGW * 64;
    for (int idx = gt; idx < 256 * 128; idx += NGT) { const int c = idx & 255, k0 = (idx >> 8) * 8; float wg[16];
#pragma unroll
        for (int r = 0; r < 16; ++r) wg[r] = w_gate_up[r * 256 + c];
        float o[8];
#pragma unroll
        for (int e = 0; e < 8; ++e) { const f32x4* wp = (const f32x4*)(w_in + (size_t)(k0 + e) * NIN + 3072); float s = 0.f;
#pragma unroll
            for (int r4 = 0; r4 < 4; ++r4) { const f32x4 w4 = wp[r4]; s += w4[0] * wg[4 * r4] + w4[1] * wg[4 * r4 + 1] + w4[2] * wg[4 * r4 + 2] + w4[3] * wg[4 * r4 + 3]; }
            o[e] = s; }
        v4u w; w.x = pk2(o[0], o[1]); w.y = pk2(o[2], o[3]); w.z = pk2(o[4], o[5]); w.w = pk2(o[6], o[7]);
        *(GAS v4u*)(WIN + (size_t)(3072 + c) * DM + k0) = w; }
    { float2* tab = (float2*)(ws + WS_ROPE);
      for (int idx = gt; idx < SEQ * 32; idx += NGT) { const int pos = idx >> 5, i = idx & 31; const double rev = (double)pos * INV_FREQ[i] * 0.15915494309189535; const float f = (float)(rev - __builtin_rint(rev));
          tab[idx] = make_float2(__builtin_amdgcn_cosf(f), __builtin_amdgcn_sinf(f)); } }
    { float* km = (float*)(ws + WS_KMEAN); for (int idx = gt; idx < NB * 32 * 512; idx += NGT) km[idx] = 0.f; }
    { const float* x = a.in[0]; const float* g = a.in[1]; bf16_t* XN = (bf16_t*)(ws + WS_XN);
      for (int m = gw; m < M; m += NGW) { const GAS f32x4* xr = (const GAS f32x4*)(x + (size_t)m * DM) + F.lane; f32x4 v[4]; float s = 0.f;
#pragma unroll
          for (int j = 0; j < 4; ++j) { v[j] = xr[64 * j]; s += (v[j].x * v[j].x + v[j].y * v[j].y) + (v[j].z * v[j].z + v[j].w * v[j].w); }
          const float rstd = 1.f / sqrtf(wave_sum(s) * (1.f / DM) + EPS);
          GAS unsigned long long* o8 = (GAS unsigned long long*)(XN + (size_t)m * DM) + F.lane;
#pragma unroll
          for (int j = 0; j < 4; ++j) { const f32x4 gg = ((const GAS f32x4*)g)[64 * j + F.lane];
              o8[64 * j] = (unsigned long long)pk2(v[j].x * rstd * gg.x, v[j].y * rstd * gg.y) | ((unsigned long long)pk2(v[j].z * rstd * gg.z, v[j].w * rstd * gg.w) << 32); } } }
}
__device__ __forceinline__ void p_final(Frame& F, const Args& a) {
    const int gw = F.vcu * NWAVES + F.wave, NGW = F.G * NWAVES; const float* g = a.in[12]; const float* ssq = (const float*)(a.ws + WS_SSQB);
    for (int m = gw; m < M; m += NGW) { GAS f32x4* yr = (GAS f32x4*)(a.out + (size_t)m * DM) + F.lane;
        const float p = (F.lane < 16) ? ssq[(size_t)m * 16 + F.lane] : 0.f; const float rstd = 1.f / sqrtf(wave_sum(p) * (1.f / DM) + EPS);
#pragma unroll
        for (int j = 0; j < 4; ++j) { const f32x4 v = yr[64 * j]; const f32x4 gg = ((const GAS f32x4*)g)[64 * j + F.lane]; yr[64 * j] = v * rstd * gg; } }
}

__global__ void __launch_bounds__(NWAVES * 64, 2) skel_fwd(Args args) {
    extern __shared__ __attribute__((aligned(16))) unsigned char lds[];
    Frame F;
    F.lds = (LAS unsigned char*)lds; F.MISC = (volatile LAS unsigned*)(F.lds + MISC_OFF);
    F.tid = threadIdx.x; F.lane = F.tid & 63; F.wave = __builtin_amdgcn_readfirstlane(F.tid >> 6);
    F.G = gridDim.x; { const int bx = blockIdx.x; F.vcu = (F.G % 8 == 0) ? (bx % 8) * (F.G / 8) + bx / 8 : bx; }
    unsigned char* ws = args.ws; F.ctl = (gu32*)(ws + WS_CTL);
    for (int u = F.tid; u < (LDS_BYTES - LDSCTL_OFF) / 4; u += NWAVES * 64) ((LAS unsigned*)(F.lds + LDSCTL_OFF))[u] = 0u;
    __syncthreads();
    XcdBarrier bar = xcd_barrier_post((unsigned*)(F.ctl + CW_BAR) + args.li * XCD_BAR_WORDS, F.MISC + 8);
    const int lo = args.ph_lo, hi = args.ph_hi;
#define IN(k) (lo <= (k) && (k) < hi)
#define BOTH(k) (IN(k) && IN((k) + 1))
#define GRID_BAR() xcd_barrier(bar)
    bf16_t* XN = (bf16_t*)(ws + WS_XN);
    if (IN(0)) { p0_prologue(F, args); if (BOTH(0)) GRID_BAR(); }
    if (IN(1)) {
        pg8::Gemm g{XN, (const bf16_t*)(ws + WS_WIN), M, NINP, DM}; pg8::StaticOrder S; S.init(M / 256, NINP / 256, F.G, (int)blockIdx.x);
        pg8::EpiInProj E{(bf16_t*)(ws + WS_Q), (bf16_t*)(ws + WS_K), (bf16_t*)(ws + WS_V), (bf16_t*)(ws + WS_GQ), (bf16_t*)(ws + WS_GK), (bf16_t*)(ws + WS_GV), (bf16_t*)(ws + WS_SR),
                         (float*)(ws + WS_LOGA), (float*)(ws + WS_KMEAN), (const float*)(ws + WS_ROPE), args.in[4]};
        pg8::gemm_phase<pg8::EpiInProj, pg8::StaticOrder, pg8::AMapStd, true, true>(F.lds + RING_OFF, g, S, E);
        if (BOTH(1)) GRID_BAR();
    }
    if (IN(2)) {
        IF1 f; f.q = (bf16_t*)(ws + WS_Q); f.k = (bf16_t*)(ws + WS_K); f.v = (bf16_t*)(ws + WS_V); f.gq = (bf16_t*)(ws + WS_GQ); f.gk = (bf16_t*)(ws + WS_GK); f.gv = (bf16_t*)(ws + WS_GV);
        f.sr = (bf16_t*)(ws + WS_SR); f.loga = (float*)(ws + WS_LOGA); f.adec = (float*)(ws + WS_ADEC); f.kmean = (float*)(ws + WS_KMEAN); f.rope = (const float2*)(ws + WS_ROPE);
        bf16_t* ymix = (bf16_t*)(ws + WS_YMIX); float* oraw = args.out;
        const int gw = F.vcu * NWAVES + F.wave, NGW = F.G * NWAVES;
        for (int i = gw * 64 + F.lane; i < M * 256; i += NGW * 64) f.adec[i] = expf(f.loga[i]);
        for (int p = gw; p < M * 8; p += NGW) moba_pair(f, ymix, p, F.lane);
        GRID_BAR();
        if (blockIdx.x < 8 && F.tid < 128) gla_rec_bh(f, oraw, (int)blockIdx.x, F.tid);
        GRID_BAR();
        for (int p = gw; p < M * 4; p += NGW) gla_norm_rh(oraw, args.in[5], f.sr, ymix, p >> 2, p & 3, F.lane);
        if (BOTH(2)) GRID_BAR();
    }
    if (IN(3)) {
        pg8::Gemm g{(const bf16_t*)(ws + WS_YMIX), (const bf16_t*)(ws + WS_WOUT), M, DM, DM}; pg8::StaticOrder S; S.init(M / 256, DM / 256, F.G, (int)blockIdx.x);
        pg8::EpiOutProj E{args.in[0], args.out, XN, args.in[7], (float*)(ws + WS_SSQA)};
        pg8::gemm_phase<pg8::EpiOutProj, pg8::StaticOrder, pg8::AMapStd, true, true>(F.lds + RING_OFF, g, S, E);
        if (BOTH(3)) GRID_BAR();
    }
    if (IN(4)) {
        pg8::Gemm g{XN, (const bf16_t*)(ws + WS_WUP), M, NUP, DM}; pg8::StaticOrder S; S.init(66, NUP / 256, F.G, (int)blockIdx.x);
        pg8::EpiUp E{(const float*)(ws + WS_SSQA), args.in[9], args.in[10], (bf16_t*)(ws + WS_ACT)};
        pg8::gemm_phase<pg8::EpiUp, pg8::StaticOrder, pg8::AMapConv, true, true>(F.lds + RING_OFF, g, S, E);
        if (BOTH(4)) GRID_BAR();
    }
    if (IN(5)) {
        pg8::Gemm g{(const bf16_t*)(ws + WS_ACT), (const bf16_t*)(ws + WS_WDOWN), M, DM, DFF}; pg8::StaticOrder S; S.init(M / 256, DM / 256, F.G, (int)blockIdx.x);
        pg8::EpiDown E{args.out, (float*)(ws + WS_SSQB)};
        pg8::gemm_phase<pg8::EpiDown, pg8::StaticOrder, pg8::AMapStd, true, true>(F.lds + RING_OFF, g, S, E);
        if (BOTH(5)) GRID_BAR();
    }
    if (IN(6)) { p_final(F, args); }
#undef IN
#undef BOTH
#undef GRID_BAR
}


extern "C" void kernel_launch(void* const* d_in, const int* in_sizes, int n_in, void* d_out, int out_size, void* d_ws, size_t ws_size, hipStream_t stream) {
    static int grid = 0;
    if (grid == 0) {
        if (n_in != 13 || in_sizes[0] != M * DM || out_size != M * DM || ws_size < WS_END) { fprintf(stderr, "kernel_launch: unexpected shapes / workspace (%d inputs, ws %zu)\n", n_in, ws_size); grid = -1; return; }
        int dev = 0, cus = 0, per_cu = 0;
        if (hipGetDevice(&dev) != hipSuccess || hipDeviceGetAttribute(&cus, hipDeviceAttributeMultiprocessorCount, dev) != hipSuccess) { grid = -1; return; }
        if (hipFuncSetAttribute((const void*)skel_fwd, hipFuncAttributeMaxDynamicSharedMemorySize, LDS_BYTES) != hipSuccess) { fprintf(stderr, "kernel_launch: hipFuncSetAttribute failed\n"); grid = -1; return; }
        if (hipOccupancyMaxActiveBlocksPerMultiprocessor(&per_cu, (const void*)skel_fwd, NWAVES * 64, LDS_BYTES) != hipSuccess || per_cu < 1) { fprintf(stderr, "kernel_launch: occupancy query says %d\n", per_cu); }
        (void)hipGetLastError();
        grid = cus;
    }
    if (grid < 0) return;
    unsigned char* ws = (unsigned char*)d_ws;
    (void)hipMemsetAsync(ws + WS_CTL, 0, CTL_ZERO_BYTES, stream);
    Args a{};
    for (int i = 0; i < 13; ++i) a.in[i] = (const float*)d_in[i];
    a.out = (float*)d_out; a.ws = ws;
    a.ph_lo = 0; a.ph_hi = 7; a.li = 0;
    hipLaunchKernelGGL(skel_fwd, dim3(grid), dim3(NWAVES * 64), LDS_BYTES, stream, a);
}
```

```cpp
#include <hip/hip_runtime.h>
#include <cstdio>
#include <cstdint>

typedef unsigned short bf16_t;
constexpr int NB = 2, SEQ = 8192, DM = 1024, M = NB * SEQ;
constexpr int NIN = 3088, DFF = 2816, NUP = 2 * DFF, NINP = 3328;
constexpr float EPS = 1e-6f;
constexpr float C2 = 0.18033688011112042f;

__device__ __forceinline__ unsigned f2bf(float f) { unsigned u = __builtin_bit_cast(unsigned, f); return (u + 0x7fffu + ((u >> 16) & 1u)) >> 16; }
__device__ __forceinline__ float bf2f(bf16_t h) { return __builtin_bit_cast(float, (unsigned)h << 16); }

__device__ const double INV_FREQ[32] = {1.0, 0.7498942093324559, 0.5623413251903491, 0.4216965034285822, 0.31622776601683794, 0.23713737056616552, 0.1778279410038923, 0.1333521432163324, 0.1, 0.07498942093324558, 0.05623413251903491, 0.042169650342858224, 0.03162277660168379, 0.023713737056616554, 0.01778279410038923, 0.01333521432163324, 0.01, 0.007498942093324558, 0.005623413251903491, 0.004216965034285823, 0.0031622776601683794, 0.0023713737056616554, 0.0017782794100389228, 0.001333521432163324, 0.001, 0.0007498942093324559, 0.0005623413251903491, 0.00042169650342858224, 0.00031622776601683794, 0.00023713737056616554, 0.00017782794100389227, 0.0001333521432163324};

__device__ __forceinline__ float wave_sum(float v) {
#pragma unroll
    for (int o = 1; o < 64; o <<= 1) v += __shfl_xor(v, o);
    return v;
}

struct IF1 { bf16_t *q, *k, *v, *gq, *gk, *gv, *sr; float *loga, *adec, *kmean; const float2* rope; };
__device__ __forceinline__ void moba_pair(const IF1& a, bf16_t* ymix, int gw, int lane) {
    const int row = gw >> 3, h = gw & 7, b = row / SEQ, t = row % SEQ, own = t >> 8;
    const bf16_t* qp = a.q + (size_t)row * 512 + 64 * h;
    float gate = -INFINITY;
    if (lane < own) { const float* km = a.kmean + ((size_t)(b * 32 + lane) * 8 + h) * 64; float s = 0.f;
        for (int p = 0; p < 64; ++p) s += bf2f(qp[p]) * km[p]; gate = s; }
    int selb[4]; int nsel = 0;
#pragma unroll
    for (int it = 0; it < 3; ++it) {
        float mv = gate; int mi = lane;
#pragma unroll
        for (int o = 1; o < 64; o <<= 1) { const float ov = __shfl_xor(mv, o); const int oi = __shfl_xor(mi, o); if (ov > mv || (ov == mv && oi < mi)) { mv = ov; mi = oi; } }
        if (mv > -INFINITY) { selb[it] = mi; nsel = it + 1; if (lane == mi) gate = -INFINITY; } else selb[it] = -1;
    }
    selb[3] = own;
    float sc[4][4];
    float mx = -INFINITY;
#pragma unroll
    for (int c = 0; c < 4; ++c) {
        const int blk = (c < 3) ? selb[c] : own; const bool valid = (c == 3) || (c < nsel);
#pragma unroll
        for (int u = 0; u < 4; ++u) { float s = -INFINITY;
            if (valid) { const int key = blk * 256 + u * 64 + lane;
                if (c < 3 || key <= t) { const bf16_t* kp = a.k + (size_t)(b * SEQ + key) * 512 + 64 * h; float d = 0.f;
                    for (int p = 0; p < 64; ++p) d += bf2f(qp[p]) * bf2f(kp[p]); s = d; } }
            sc[c][u] = s; mx = fmaxf(mx, s); }
    }
#pragma unroll
    for (int o = 1; o < 64; o <<= 1) mx = fmaxf(mx, __shfl_xor(mx, o));
    float l = 0.f;
#pragma unroll
    for (int c = 0; c < 4; ++c)
#pragma unroll
        for (int u = 0; u < 4; ++u) { const float pv = (sc[c][u] == -INFINITY) ? 0.f : exp2f(sc[c][u] - mx); sc[c][u] = pv; l += pv; }
    l = wave_sum(l);
    float acc = 0.f;
#pragma unroll
    for (int c = 0; c < 4; ++c) {
        const int blk = (c < 3) ? selb[c] : own; const bool valid = (c == 3) || (c < nsel);
        if (valid) {
#pragma unroll
            for (int u = 0; u < 4; ++u) {
                for (int j = 0; j < 64; ++j) { const float pj = __shfl(sc[c][u], j); const int key = blk * 256 + u * 64 + j;
                    acc += pj * bf2f(a.v[(size_t)(b * SEQ + key) * 512 + 64 * h + lane]); } } }
    }
    ymix[(size_t)row * 1024 + 64 * h + lane] = (bf16_t)f2bf(acc / l);
}

__device__ __forceinline__ void gla_rec_bh(const IF1& a, float* oraw, int bh, int v) {
    const int b = bh >> 2, h = bh & 3;
    float S[64];
#pragma unroll
    for (int d = 0; d < 64; ++d) S[d] = 0.f;
    for (int t = 0; t < SEQ; ++t) {
        const size_t row = (size_t)b * SEQ + t;
        const float vv = bf2f(a.gv[row * 512 + 128 * h + v]);
        const float* ad = a.adec + row * 256 + 64 * h; const bf16_t* kp = a.gk + row * 256 + 64 * h; const bf16_t* qp = a.gq + row * 256 + 64 * h;
        float o = 0.f;
#pragma unroll
        for (int d0 = 0; d0 < 64; d0 += 8) {
#pragma unroll
            for (int d = d0; d < d0 + 8; ++d) { S[d] = ad[d] * S[d] + bf2f(kp[d]) * vv; o += bf2f(qp[d]) * S[d]; }
            asm volatile("" ::: "memory"); }
        oraw[row * 512 + 128 * h + v] = o;
    }
}

__device__ __forceinline__ void gla_norm_rh(const float* oraw, const float* g, const bf16_t* sr, bf16_t* ymix, int row, int h, int lane) {
    const float o0 = oraw[(size_t)row * 512 + 128 * h + lane], o1 = oraw[(size_t)row * 512 + 128 * h + 64 + lane];
    const float ms = wave_sum(o0 * o0 + o1 * o1) * (1.0f / 128.0f); const float rstd = 1.0f / sqrtf(ms + EPS);
    const float y0 = o0 * rstd * g[128 * h + lane] * bf2f(sr[(size_t)row * 512 + 128 * h + lane]);
    const float y1 = o1 * rstd * g[128 * h + 64 + lane] * bf2f(sr[(size_t)row * 512 + 128 * h + 64 + lane]);
    ymix[(size_t)row * 1024 + 512 + 128 * h + lane] = (bf16_t)f2bf(y0); ymix[(size_t)row * 1024 + 512 + 128 * h + 64 + lane] = (bf16_t)f2bf(y1);
}


namespace pg8 {
#define PG8_LAS __attribute__((address_space(3)))
typedef unsigned short bf16_t;
typedef short bf16x8 __attribute__((ext_vector_type(8)));
typedef float f32x4 __attribute__((ext_vector_type(4)));
typedef unsigned u32x4 __attribute__((ext_vector_type(4)));
constexpr int BM = 256, BK = 64, HALF = 128, HTB = HALF * BK * 2  , STAGE_BYTES = 8 * HTB, NXCD = 8, WGM = 8;

__host__ __device__ __forceinline__ int lds_byte(int r, int c) { const int st = (r >> 4) * 2 + (c >> 5), rr = r & 15, cc = c & 31, ob = rr * 64 + cc * 2; return st * 1024 + (ob ^ (((ob >> 9) & 1) << 5)); }
__host__ __device__ __forceinline__ void stage_rc(int b, int& R, int& C) { const int st = b / 1024, sb = b % 1024, swz = sb ^ (((sb >> 9) & 1) << 5); R = (st >> 1) * 16 + swz / 64; C = (st & 1) * 32 + (swz % 64) / 2; }
__host__ __device__ __forceinline__ int perm32(int rho) { const int n = rho >> 4, i = rho & 15; return 8 * (i >> 2) + 4 * n + (i & 3); }

struct Unit { int pm, pn; };
struct Gemm { const bf16_t* A; const bf16_t* Bt; int M, N, K; };

struct StaticOrder {
    int nM, nN, nwg, G, c;
    __host__ __device__ void init(int nM_, int nN_, int G_, int c_) { nM = nM_; nN = nN_; nwg = nM * nN; G = G_; c = c_; }
    __host__ __device__ bool next(int i, Unit& u) const {
        const long L = (long)i * G + c; if (L >= nwg) return false;
        int wgid = (int)L; { const int q = nwg / NXCD, r = nwg % NXCD, xcd = wgid % NXCD, off = wgid / NXCD; wgid = (xcd < r ? xcd * (q + 1) : r * (q + 1) + (xcd - r) * q) + off; }
        const int nig = WGM * nN, gid = wgid / nig, fm = gid * WGM, gsz = (nM - fm) < WGM ? (nM - fm) : WGM;
        u.pm = fm + ((wgid % nig) % gsz); u.pn = (wgid % nig) / gsz; return true;
    }
    __device__ __forceinline__ void a_ready(const Unit&) const {}
    __device__ __forceinline__ void done(const Unit&) const {}
};

struct AMapStd { static constexpr int HALF_ROWS = 128; static __device__ __forceinline__ int rowmap(int R) { return R; } static __device__ __forceinline__ int tile_row(int pm) { return pm * 256; } };
struct AMapConv { static constexpr int HALF_ROWS = 64; static __device__ __forceinline__ int rowmap(int R) { return 126 * (R >> 6) + (R & 63); }
    static __device__ __forceinline__ int tile_row(int pm) { return (pm / 33) * SEQ + 252 * (pm % 33) - 2; } };

__device__ __forceinline__ unsigned cvt_pk_bf16(float lo, float hi) { unsigned r; asm volatile("v_cvt_pk_bf16_f32 %0, %1, %2" : "=v"(r) : "v"(lo), "v"(hi)); return r; }
__device__ __forceinline__ u32x4 pack8(const f32x4 a, const f32x4 b) { u32x4 w; w.x = cvt_pk_bf16(a[0], a[1]); w.y = cvt_pk_bf16(a[2], a[3]); w.z = cvt_pk_bf16(b[0], b[1]); w.w = cvt_pk_bf16(b[2], b[3]); return w; }
__device__ __forceinline__ float silu_f(float r) { return r * __builtin_amdgcn_rcpf(1.0f + __expf(-r)); }

struct EpiInProj {
    static constexpr bool PERM = true, AFTER_DRAIN = false;
    bf16_t *q, *k, *v, *gq, *gk, *gv, *sr; float *loga, *kmean; const float* rope; const float* b_gate;
    template <bool ISQ> __device__ __forceinline__ void rope_tile(const f32x4 (&acc)[2][2][4][2], const Unit& u, int row0, int cw, int fr) const {
        bf16_t* dst = ISQ ? q : k; const int colt = (u.pn & 1) * 256; const float sc = ISQ ? C2 : 1.0f;
        float ks[2][8];
#pragma unroll
        for (int bj = 0; bj < 2; ++bj)
#pragma unroll
            for (int e = 0; e < 8; ++e) ks[bj][e] = 0.f;
#pragma unroll
        for (int ai = 0; ai < 2; ++ai)
#pragma unroll
            for (int m = 0; m < 4; ++m) { const int row = row0 + ai * HALF + m * 16; const int t = row & (SEQ - 1);
#pragma unroll
                for (int bj = 0; bj < 2; ++bj) { const int col = colt + bj * HALF + cw; const int i0 = (col & 63) >> 1;
                    const float* rp = rope + (size_t)(t * 32 + i0) * 2; const f32x4 c0 = *(const f32x4*)rp, c1 = *(const f32x4*)(rp + 4);
                    const f32x4 a = acc[ai][bj][m][0], b = acc[ai][bj][m][1]; float o[8];
                    o[0] = a[0] * c0[0] - a[1] * c0[1]; o[1] = a[1] * c0[0] + a[0] * c0[1];
                    o[2] = a[2] * c0[2] - a[3] * c0[3]; o[3] = a[3] * c0[2] + a[2] * c0[3];
                    o[4] = b[0] * c1[0] - b[1] * c1[1]; o[5] = b[1] * c1[0] + b[0] * c1[1];
                    o[6] = b[2] * c1[2] - b[3] * c1[3]; o[7] = b[3] * c1[2] + b[2] * c1[3];
                    if (!ISQ) {
#pragma unroll
                        for (int e = 0; e < 8; ++e) ks[bj][e] += o[e]; }
                    u32x4 w; w.x = cvt_pk_bf16(o[0] * sc, o[1] * sc); w.y = cvt_pk_bf16(o[2] * sc, o[3] * sc); w.z = cvt_pk_bf16(o[4] * sc, o[5] * sc); w.w = cvt_pk_bf16(o[6] * sc, o[7] * sc);
                    *(u32x4*)(dst + (size_t)row * 512 + col) = w; }
                if (!ISQ) {
#pragma unroll
                    for (int bj = 0; bj < 2; ++bj)
#pragma unroll
                        for (int e = 0; e < 8; ++e) asm volatile("" : "+v"(ks[bj][e])); }
                asm volatile("" ::: "memory"); __builtin_amdgcn_sched_barrier(0); }
        if (!ISQ) {
#pragma unroll
            for (int bj = 0; bj < 2; ++bj)
#pragma unroll
                for (int e = 0; e < 8; ++e) { float s = ks[bj][e]; s += __shfl_xor(s, 1); s += __shfl_xor(s, 2); s += __shfl_xor(s, 4); s += __shfl_xor(s, 8);
                    if (fr == 0) __hip_atomic_fetch_add(kmean + (size_t)u.pm * 512 + colt + bj * HALF + cw + e, s * (1.0f / 256.0f), __ATOMIC_RELAXED, __HIP_MEMORY_SCOPE_AGENT); }
        }
    }
    __device__ __forceinline__ void operator()(const f32x4 (&acc)[2][2][4][2], const Unit& u, int wr, int wc, int fr, int fq) const {
        const int pn = u.pn; const int row0 = u.pm * BM + wr * 64 + fr; const int cw = wc * 32 + 8 * fq;
        if (pn < 2) { rope_tile<true>(acc, u, row0, cw, fr); return; }
        if (pn < 4) { rope_tile<false>(acc, u, row0, cw, fr); return; }
        if (pn == 12) {
            f32x4 bv[2][2];
#pragma unroll
            for (int bj = 0; bj < 2; ++bj)
#pragma unroll
                for (int n = 0; n < 2; ++n) bv[bj][n] = *(const f32x4*)(b_gate + bj * HALF + cw + 4 * n);
#pragma unroll
            for (int ai = 0; ai < 2; ++ai)
#pragma unroll
                for (int m = 0; m < 4; ++m) { const int row = row0 + ai * HALF + m * 16;
#pragma unroll
                    for (int bj = 0; bj < 2; ++bj)
#pragma unroll
                        for (int n = 0; n < 2; ++n) { const f32x4 z = acc[ai][bj][m][n] + bv[bj][n]; f32x4 la;
#pragma unroll
                            for (int e = 0; e < 4; ++e) la[e] = (fminf(z[e], 0.f) - __logf(1.0f + __expf(-fabsf(z[e])))) * (1.0f / 16.0f);
                            *(f32x4*)(loga + (size_t)row * 256 + bj * HALF + cw + 4 * n) = la; } }
            return;
        }
        bf16_t* dst; int ld, colt, mode;
        if (pn < 6) { dst = v; ld = 512; colt = (pn - 4) * 256; mode = 0; }
        else if (pn == 6) { dst = gq; ld = 256; colt = 0; mode = 1; }
        else if (pn == 7) { dst = gk; ld = 256; colt = 0; mode = 0; }
        else if (pn < 10) { dst = gv; ld = 512; colt = (pn - 8) * 256; mode = 0; }
        else { dst = sr; ld = 512; colt = (pn - 10) * 256; mode = 2; }
        const float sc = (mode == 1) ? 0.125f : 1.0f;
#pragma unroll
        for (int ai = 0; ai < 2; ++ai)
#pragma unroll
            for (int m = 0; m < 4; ++m) { bf16_t* rowp = dst + (size_t)(row0 + ai * HALF + m * 16) * ld + colt + cw;
#pragma unroll
                for (int bj = 0; bj < 2; ++bj) { f32x4 a = acc[ai][bj][m][0], b = acc[ai][bj][m][1];
                    if (mode == 2) {
#pragma unroll
                        for (int e = 0; e < 4; ++e) { a[e] = silu_f(a[e]); b[e] = silu_f(b[e]); } }
                    else { a = a * sc; b = b * sc; }
                    *(u32x4*)(rowp + bj * HALF) = pack8(a, b); } }
    }
};

struct EpiOutProj {
    static constexpr bool PERM = true, AFTER_DRAIN = false;
    const float* x; float* h; bf16_t* hs; const float* g; float* ssq;
    __device__ __forceinline__ void operator()(const f32x4 (&acc)[2][2][4][2], const Unit& u, int wr, int wc, int fr, int fq) const {
        const int row0 = u.pm * BM + wr * 64 + fr; const int col0 = u.pn * BM + wc * 32 + 8 * fq;
        f32x4 gv[2][2];
#pragma unroll
        for (int bj = 0; bj < 2; ++bj)
#pragma unroll
            for (int n = 0; n < 2; ++n) gv[bj][n] = *(const f32x4*)(g + col0 + bj * HALF + 4 * n);
#pragma unroll
        for (int ai = 0; ai < 2; ++ai)
#pragma unroll
            for (int m = 0; m < 4; ++m) { const int row = row0 + ai * HALF + m * 16; const size_t off = (size_t)row * DM + col0; float ss = 0.f;
#pragma unroll
                for (int bj = 0; bj < 2; ++bj) { const f32x4 xa = *(const f32x4*)(x + off + bj * HALF), xb = *(const f32x4*)(x + off + bj * HALF + 4);
                    const f32x4 ha = xa + acc[ai][bj][m][0], hb = xb + acc[ai][bj][m][1];
                    *(f32x4*)(h + off + bj * HALF) = ha; *(f32x4*)(h + off + bj * HALF + 4) = hb;
                    ss += (ha[0] * ha[0] + ha[1] * ha[1]) + (ha[2] * ha[2] + ha[3] * ha[3]) + (hb[0] * hb[0] + hb[1] * hb[1]) + (hb[2] * hb[2] + hb[3] * hb[3]);
                    *(u32x4*)(hs + off + bj * HALF) = pack8(ha * gv[bj][0], hb * gv[bj][1]); }
                ss += __shfl_xor(ss, 16); ss += __shfl_xor(ss, 32);
                if (fq == 0) ssq[(size_t)row * 16 + u.pn * 4 + wc] = ss; }
    }
};
struct EpiDown {
    static constexpr bool PERM = true, AFTER_DRAIN = false;
    float* y; float* ssq;
    __device__ __forceinline__ void operator()(const f32x4 (&acc)[2][2][4][2], const Unit& u, int wr, int wc, int fr, int fq) const {
        const int row0 = u.pm * BM + wr * 64 + fr; const int col0 = u.pn * BM + wc * 32 + 8 * fq;
#pragma unroll
        for (int ai = 0; ai < 2; ++ai)
#pragma unroll
            for (int m = 0; m < 4; ++m) { const int row = row0 + ai * HALF + m * 16; const size_t off = (size_t)row * DM + col0; float ss = 0.f;
#pragma unroll
                for (int bj = 0; bj < 2; ++bj) { const f32x4 xa = *(const f32x4*)(y + off + bj * HALF), xb = *(const f32x4*)(y + off + bj * HALF + 4);
                    const f32x4 ha = xa + acc[ai][bj][m][0], hb = xb + acc[ai][bj][m][1];
                    *(f32x4*)(y + off + bj * HALF) = ha; *(f32x4*)(y + off + bj * HALF + 4) = hb;
                    ss += (ha[0] * ha[0] + ha[1] * ha[1]) + (ha[2] * ha[2] + ha[3] * ha[3]) + (hb[0] * hb[0] + hb[1] * hb[1]) + (hb[2] * hb[2] + hb[3] * hb[3]); }
                ss += __shfl_xor(ss, 16); ss += __shfl_xor(ss, 32);
                if (fq == 0) ssq[(size_t)row * 16 + u.pn * 4 + wc] = ss; }
    }
};
struct EpiUp {
    static constexpr bool PERM = true, AFTER_DRAIN = false;
    const float* ssq; const float* cw; const float* cb; bf16_t* act;
    __device__ __forceinline__ void operator()(const f32x4 (&acc)[2][2][4][2], const Unit& u, int wr, int wc, int fr, int fq) const {
        const int b = u.pm / 33, j = u.pm % 33; const int tb = 252 * j - 2 + 126 * wr;
        const int ch0 = u.pn * 128 + wc * 32 + 8 * fq;
        float rs[8];
#pragma unroll
        for (int g8 = 0; g8 < 8; ++g8) { int row = b * SEQ + tb + 16 * g8 + fr; row = row < 0 ? 0 : (row > M - 1 ? M - 1 : row);
            const f32x4* sp = (const f32x4*)(ssq + (size_t)row * 16); const f32x4 s0 = sp[0], s1 = sp[1], s2 = sp[2], s3 = sp[3];
            const float s = ((s0[0] + s0[1]) + (s0[2] + s0[3])) + ((s1[0] + s1[1]) + (s1[2] + s1[3])) + ((s2[0] + s2[1]) + (s2[2] + s2[3])) + ((s3[0] + s3[1]) + (s3[2] + s3[3]));
            rs[g8] = __builtin_amdgcn_rsqf(s * (1.0f / DM) + EPS);
            asm volatile("" : "+v"(rs[g8]) :: "memory"); __builtin_amdgcn_sched_barrier(0); }
        const int lane = fq * 16 + fr; const int src1 = ((lane & 48) | ((fr + 15) & 15)) * 4, src2 = ((lane & 48) | ((fr + 14) & 15)) * 4;
        const bool last1 = (fr == 15), last2 = (fr >= 14);
#pragma unroll
        for (int n = 0; n < 2; ++n) {
            const int ch = ch0 + 4 * n;
            const f32x4 wg0 = *(const f32x4*)(cw + ch), wg1 = *(const f32x4*)(cw + NUP + ch), wg2 = *(const f32x4*)(cw + 2 * NUP + ch), bg = *(const f32x4*)(cb + ch);
            const f32x4 wv0 = *(const f32x4*)(cw + DFF + ch), wv1 = *(const f32x4*)(cw + NUP + DFF + ch), wv2 = *(const f32x4*)(cw + 2 * NUP + DFF + ch), bvv = *(const f32x4*)(cb + DFF + ch);
            f32x4 pg = {0.f, 0.f, 0.f, 0.f}, pv = {0.f, 0.f, 0.f, 0.f};
#pragma unroll
            for (int g8 = 0; g8 < 8; ++g8) { const int ai = g8 >> 2, m = g8 & 3; const int qi = 16 * g8 + fr; const int t = tb + qi; const bool t1ok = t >= 1, t2ok = t >= 2;
                const f32x4 cg = acc[ai][0][m][n] * rs[g8], cv = acc[ai][1][m][n] * rs[g8]; f32x4 o;
#pragma unroll
                for (int e = 0; e < 4; ++e) {
                    float g1 = __builtin_bit_cast(float, __builtin_amdgcn_ds_bpermute(src1, __builtin_bit_cast(int, last1 ? pg[e] : cg[e])));
                    float g2 = __builtin_bit_cast(float, __builtin_amdgcn_ds_bpermute(src2, __builtin_bit_cast(int, last2 ? pg[e] : cg[e])));
                    g1 = t1ok ? g1 : 0.f; g2 = t2ok ? g2 : 0.f;
                    const float gate = silu_f(bg[e] + wg2[e] * cg[e] + wg1[e] * g1 + wg0[e] * g2);
                    float v1 = __builtin_bit_cast(float, __builtin_amdgcn_ds_bpermute(src1, __builtin_bit_cast(int, last1 ? pv[e] : cv[e])));
                    float v2 = __builtin_bit_cast(float, __builtin_amdgcn_ds_bpermute(src2, __builtin_bit_cast(int, last2 ? pv[e] : cv[e])));
                    v1 = t1ok ? v1 : 0.f; v2 = t2ok ? v2 : 0.f;
                    o[e] = gate * (bvv[e] + wv2[e] * cv[e] + wv1[e] * v1 + wv0[e] * v2); }
                if (qi >= 2 && t < SEQ) { typedef unsigned u32x2v __attribute__((ext_vector_type(2))); u32x2v w; w.x = cvt_pk_bf16(o[0], o[1]); w.y = cvt_pk_bf16(o[2], o[3]);
                    *(u32x2v*)(act + (size_t)(b * SEQ + t) * DFF + ch) = w; }
                pg = cg; pv = cv; __builtin_amdgcn_sched_barrier(0); }
        }
    }
};
template <class Epi, class Sched, class AMap, bool ALIGN_EPI = false, bool SP2 = false>
__device__ __forceinline__ void gemm_phase(PG8_LAS unsigned char* lds, const Gemm g, const Sched& S, const Epi& E) {
    const int tid = threadIdx.x, wid = __builtin_amdgcn_readfirstlane(tid >> 6), lane = tid & 63, wr = wid >> 2, wc = wid & 3, fr = lane & 15, fq = lane >> 4;
    const int K = g.K, nt = K / BK;
    unsigned voffA[2], voffB[2];
#pragma unroll
    for (int i = 0; i < 2; ++i) { int R, C; stage_rc(tid * 16 + i * 8192, R, C); const int Rb = Epi::PERM ? ((R & ~31) + perm32(R & 31)) : R;
        voffA[i] = (unsigned)(AMap::rowmap(R) * K + C) * 2u; voffB[i] = (unsigned)(Rb * K + C) * 2u; }
    const size_t kstep = (size_t)(BK * 2);
    const size_t hstepA = (size_t)AMap::HALF_ROWS * K * 2, hstepB = (size_t)HALF * K * 2;
    const size_t tstepB = 2 * hstepB;
    const unsigned ldsw = (unsigned)wid * 1024u;
    const int aoff = lds_byte(wr * 64 + fr, fq * 8), boff = lds_byte(wc * 32 + fr, fq * 8);
#define PG8_SA(b, h) (((b) * 2 + (h)) * HTB)
#define PG8_SB(b, h) ((4 + (b) * 2 + (h)) * HTB)
#define PG8_STAGE(bufoff, gbase, voff) do { _Pragma("unroll") for (int _i = 0; _i < 2; ++_i) \
        __builtin_amdgcn_global_load_lds((const unsigned*)((const char*)(gbase) + (voff)[_i]), (PG8_LAS unsigned*)(lds + (bufoff) + ldsw + _i * 8192), 16, 0, 0); } while (0)
#define PG8_LDA(dst, b, h) do { _Pragma("unroll") for (int m = 0; m < 4; ++m) _Pragma("unroll") for (int k = 0; k < 2; ++k) dst[m][k] = *(const PG8_LAS bf16x8*)(lds + PG8_SA(b, h) + aoff + m * 2048 + k * 1024); } while (0)
#define PG8_LDB(dst, b, h) do { _Pragma("unroll") for (int n = 0; n < 2; ++n) _Pragma("unroll") for (int k = 0; k < 2; ++k) dst[n][k] = *(const PG8_LAS bf16x8*)(lds + PG8_SB(b, h) + boff + n * 2048 + k * 1024); } while (0)
#define PG8_MMA(ai, bj, At, Bt) do { __builtin_amdgcn_s_setprio(1); _Pragma("unroll") for (int m = 0; m < 4; ++m) _Pragma("unroll") for (int n = 0; n < 2; ++n) _Pragma("unroll") for (int k = 0; k < 2; ++k) \
        acc[ai][bj][m][n] = __builtin_amdgcn_mfma_f32_16x16x32_bf16(Bt[n][k], At[m][k], acc[ai][bj][m][n], 0, 0, 0); __builtin_amdgcn_s_setprio(0); } while (0)
#define PG8_WAIT_V(n) asm volatile("s_waitcnt vmcnt(" #n ")" ::: "memory")
#define PG8_WAIT_L(n) asm volatile("s_waitcnt lgkmcnt(" #n ")" ::: "memory")
#define PG8_BAR __builtin_amdgcn_s_barrier()
#define PG8_SCHED __builtin_amdgcn_sched_barrier(0)
    Unit cur, nxt; int ui = 0;
    if (!S.next(0, cur)) return;
    f32x4 acc[2][2][4][2];
#pragma unroll
    for (int a = 0; a < 2; ++a)
#pragma unroll
        for (int b = 0; b < 2; ++b)
#pragma unroll
            for (int m = 0; m < 4; ++m)
#pragma unroll
                for (int n = 0; n < 2; ++n) acc[a][b][m][n] = (f32x4){0.f, 0.f, 0.f, 0.f};
    bf16x8 At[4][2], B0[2][2], B1[2][2];
    const char* cA = (const char*)g.A + (long)AMap::tile_row(cur.pm) * K * 2; const char* cB = (const char*)g.Bt + (size_t)cur.pn * tstepB;
    S.a_ready(cur);
    if constexpr (SP2) {
        PG8_STAGE(PG8_SB(0, 0), cB, voffB); PG8_STAGE(PG8_SB(0, 1), cB + hstepB, voffB); PG8_STAGE(PG8_SA(0, 0), cA, voffA); PG8_STAGE(PG8_SA(0, 1), cA + hstepA, voffA);
        if (wr == 1) PG8_BAR;
        PG8_WAIT_V(2); PG8_BAR;
        PG8_STAGE(PG8_SB(1, 0), cB + kstep, voffB); PG8_STAGE(PG8_SA(1, 0), cA + kstep, voffA); PG8_STAGE(PG8_SB(1, 1), cB + hstepB + kstep, voffB);
        PG8_WAIT_V(6); PG8_BAR;
    } else {
        PG8_STAGE(PG8_SB(0, 0), cB, voffB); PG8_STAGE(PG8_SA(0, 0), cA, voffA); PG8_STAGE(PG8_SB(0, 1), cB + hstepB, voffB); PG8_STAGE(PG8_SA(0, 1), cA + hstepA, voffA);
        if (wr == 1) PG8_BAR;
        PG8_WAIT_V(4); PG8_BAR;
        PG8_STAGE(PG8_SB(1, 0), cB + kstep, voffB); PG8_STAGE(PG8_SA(1, 0), cA + kstep, voffA); PG8_STAGE(PG8_SB(1, 1), cB + hstepB + kstep, voffB);
        PG8_WAIT_V(6); PG8_BAR;
    }
    for (;;) {
        const bool has_next = S.next(ui + 1, nxt);
        const char* nA = has_next ? (const char*)g.A + (long)AMap::tile_row(nxt.pm) * K * 2 : cA; const char* nB = has_next ? (const char*)g.Bt + (size_t)nxt.pn * tstepB : cB;
        for (int t = 0; t < nt; t += 2) {
            const bool last = (t == nt - 2);
            const char* a1 = cA + (size_t)(t + 1) * kstep;
            const char* a2 = last ? nA : cA + (size_t)(t + 2) * kstep; const char* b2 = last ? nB : cB + (size_t)(t + 2) * kstep;
            const char* a3 = a2 + kstep; const char* b3 = b2 + kstep;
            if (last && has_next) S.a_ready(nxt);
            if constexpr (SP2) {
            PG8_LDB(B0, 0, 0); PG8_LDB(B1, 0, 1); PG8_SCHED; PG8_LDA(At, 0, 0); PG8_STAGE(PG8_SA(1, 1), a1 + hstepA, voffA);
            PG8_WAIT_V(8); PG8_WAIT_L(0); PG8_BAR; PG8_MMA(0, 0, At, B0); PG8_MMA(0, 1, At, B1); PG8_BAR; PG8_SCHED;
            PG8_LDA(At, 0, 1); PG8_STAGE(PG8_SB(0, 0), b2, voffB); PG8_STAGE(PG8_SB(0, 1), b2 + hstepB, voffB); PG8_STAGE(PG8_SA(0, 0), a2, voffA);
            PG8_WAIT_V(8); PG8_WAIT_L(0); PG8_BAR; PG8_MMA(1, 0, At, B0); PG8_MMA(1, 1, At, B1); PG8_BAR; PG8_SCHED;
            PG8_LDB(B0, 1, 0); PG8_LDB(B1, 1, 1); PG8_SCHED; PG8_LDA(At, 1, 0); PG8_STAGE(PG8_SA(0, 1), a2 + hstepA, voffA);
            PG8_WAIT_V(8); PG8_WAIT_L(0); PG8_BAR; PG8_MMA(0, 0, At, B0); PG8_MMA(0, 1, At, B1); PG8_BAR; PG8_SCHED;
            PG8_LDA(At, 1, 1); PG8_STAGE(PG8_SB(1, 0), b3, voffB); PG8_STAGE(PG8_SB(1, 1), b3 + hstepB, voffB); PG8_STAGE(PG8_SA(1, 0), a3, voffA);
            PG8_WAIT_V(8); PG8_WAIT_L(0); PG8_BAR; PG8_MMA(1, 0, At, B0); PG8_MMA(1, 1, At, B1); PG8_BAR; PG8_SCHED;
            } else {
            PG8_LDB(B0, 0, 0); PG8_SCHED; PG8_LDA(At, 0, 0); PG8_STAGE(PG8_SA(1, 1), a1 + hstepA, voffA);
            PG8_WAIT_L(8); PG8_BAR; PG8_WAIT_L(0); PG8_MMA(0, 0, At, B0); PG8_BAR; PG8_SCHED;
            PG8_LDB(B1, 0, 1); PG8_STAGE(PG8_SB(0, 0), b2, voffB);
            PG8_BAR; PG8_WAIT_L(0); PG8_MMA(0, 1, At, B1); PG8_BAR;
            PG8_LDA(At, 0, 1); PG8_STAGE(PG8_SA(0, 0), a2, voffA);
            PG8_BAR; PG8_WAIT_L(0); PG8_MMA(1, 0, At, B0); PG8_BAR; PG8_SCHED;
            PG8_STAGE(PG8_SB(0, 1), b2 + hstepB, voffB);
            PG8_WAIT_V(6); PG8_BAR; PG8_MMA(1, 1, At, B1); PG8_BAR;
            PG8_LDB(B0, 1, 0); PG8_SCHED; PG8_LDA(At, 1, 0); PG8_STAGE(PG8_SA(0, 1), a2 + hstepA, voffA);
            PG8_WAIT_L(8); PG8_BAR; PG8_WAIT_L(0); PG8_MMA(0, 0, At, B0); PG8_BAR; PG8_SCHED;
            PG8_LDB(B1, 1, 1); PG8_STAGE(PG8_SB(1, 0), b3, voffB);
            PG8_BAR; PG8_WAIT_L(0); PG8_MMA(0, 1, At, B1); PG8_BAR;
            PG8_LDA(At, 1, 1); PG8_STAGE(PG8_SA(1, 0), a3, voffA);
            PG8_BAR; PG8_WAIT_L(0); PG8_MMA(1, 0, At, B0); PG8_BAR; PG8_SCHED;
            PG8_STAGE(PG8_SB(1, 1), b3 + hstepB, voffB);
            PG8_WAIT_V(6); PG8_BAR; PG8_MMA(1, 1, At, B1); PG8_BAR;
            }
        }
        if constexpr (ALIGN_EPI) { if (wr == 0) PG8_BAR; }
        if constexpr (!Epi::AFTER_DRAIN) { E(acc, cur, wr, wc, fr, fq); S.done(cur); }
        if (!has_next) break;
#pragma unroll
        for (int a = 0; a < 2; ++a)
#pragma unroll
            for (int b = 0; b < 2; ++b)
#pragma unroll
                for (int m = 0; m < 4; ++m)
#pragma unroll
                    for (int n = 0; n < 2; ++n) acc[a][b][m][n] = (f32x4){0.f, 0.f, 0.f, 0.f};
        cur = nxt; cA = nA; cB = nB; ++ui;
        if constexpr (ALIGN_EPI) { if (wr == 1) PG8_BAR; }
    }
    PG8_WAIT_V(0);
    if constexpr (!ALIGN_EPI) { if (wr == 0) PG8_BAR; }
    PG8_BAR;
    if constexpr (Epi::AFTER_DRAIN) { E.fused(acc, cur, wr, wc, fr, fq, lds, wid, lane); S.done(cur); }
#undef PG8_SA
#undef PG8_SB
#undef PG8_STAGE
#undef PG8_LDA
#undef PG8_LDB
#undef PG8_MMA
#undef PG8_WAIT_V
#undef PG8_WAIT_L
#undef PG8_BAR
#undef PG8_SCHED
}
}

#include <hip/hip_bf16.h>
#include <cmath>
namespace attn_body {
using bf16=__hip_bfloat16;
using bf16x8=__attribute__((ext_vector_type(8)))short;
using s16x4=__attribute__((ext_vector_type(4)))short;
using f32x16=__attribute__((ext_vector_type(16)))float;
using u32x4=__attribute__((ext_vector_type(4)))unsigned;
using f32x4_t=__attribute__((ext_vector_type(4)))float;
constexpr int BATCH=2,NHEAD=8,SEQ=8192,D=64,DM=NHEAD*D,OPITCH=1024;
constexpr int NW=8,QBLK=32,QB=QBLK*NW,KVBLK=64,NQB=SEQ/QB;
constexpr int ATTN_PITCH=DM, ATTN_UNIT_ROWS=QB;
__device__ __forceinline__ int crow(int r,int hi){return (r&3)+8*(r>>2)+4*hi;}
#define SBAR() __builtin_amdgcn_sched_barrier(0)
__device__ __forceinline__ void cmask(f32x16&p0,f32x16&p1,int jb,int qrel,int hi){
  const float NEG=-INFINITY; int kb=64*jb+4*hi;
  #pragma unroll
  for(int r=0;r<16;++r){int kv=kb+(r&3)+8*(r>>2); if(kv>qrel)p0[r]=NEG; if(kv+32>qrel)p1[r]=NEG;}
}

constexpr int NSLOT=3, SLOTB=8192;
constexpr int LDS_K=0, LDS_V=NSLOT*SLOTB, LDS_WS=2*NSLOT*SLOTB, LDS_OST=LDS_WS+NW*64*4, LDS_BYTES=LDS_OST+NW*4096;
constexpr float C2=0.125f*1.4426950408889634f;
__device__ __forceinline__ void glds16(const void*gsrc,unsigned lds_dst){unsigned keep;
  asm volatile("s_mov_b32 %0, m0\n\ts_mov_b32 m0, %2\n\ts_nop 0\n\tglobal_load_lds_dwordx4 %1, off\n\ts_mov_b32 m0, %0":"=&s"(keep):"v"(gsrc),"s"(lds_dst):"memory");}
__device__ __forceinline__ float max3f(float a,float b,float c){float r;asm("v_max3_f32 %0, %1, %2, %3":"=v"(r):"v"(a),"v"(b),"v"(c));return r;}
__device__ __forceinline__ float max2f(float a,float b){float r;asm("v_max_f32_e32 %0, %1, %2":"=v"(r):"v"(a),"v"(b));return r;}
__device__ __forceinline__ float fadd_s(float a,float b){float r;asm("v_add_f32_e32 %0, %1, %2":"=v"(r):"v"(a),"v"(b));return r;}
__device__ __forceinline__ float fsub_s(float a,float b){float r;asm("v_sub_f32_e32 %0, %1, %2":"=v"(r):"v"(a),"v"(b));return r;}
typedef float f32x2_t __attribute__((ext_vector_type(2))); typedef __bf16 bf16x2_t __attribute__((ext_vector_type(2)));
__device__ __forceinline__ unsigned cvtpk_s(float lo,float hi){f32x2_t v={lo,hi};bf16x2_t b=__builtin_convertvector(v,bf16x2_t);return __builtin_bit_cast(unsigned,b);}
#define WAIT_BAR(N) asm volatile("s_waitcnt vmcnt(" #N ") lgkmcnt(0)\n\ts_barrier":::"memory")

__device__ __forceinline__ void qkt(f32x16&p0,f32x16&p1,const char*Kslot,const bf16x8*qr,const f32x16&negm,int r32,int hi){
  const char*kb=Kslot+hi*1024+r32*16;
  #pragma unroll
  for(int d0=0;d0<4;++d0){
    const bf16x8 b0=*reinterpret_cast<const bf16x8*>(kb+d0*2048);
    const bf16x8 b1=*reinterpret_cast<const bf16x8*>(kb+d0*2048+512);
    if(d0==0){p0=__builtin_amdgcn_mfma_f32_32x32x16_bf16(b0,qr[0],negm,0,0,0);p1=__builtin_amdgcn_mfma_f32_32x32x16_bf16(b1,qr[0],negm,0,0,0);}
    else{p0=__builtin_amdgcn_mfma_f32_32x32x16_bf16(b0,qr[d0],p0,0,0,0);p1=__builtin_amdgcn_mfma_f32_32x32x16_bf16(b1,qr[d0],p1,0,0,0);}}
}
typedef __attribute__((address_space(3))) const char* lds_cptr;
typedef short v4i16_t __attribute__((ext_vector_type(4)));
__device__ __forceinline__ void kload8(bf16x8*kf,lds_cptr kp){
  kf[0]=*(const __attribute__((address_space(3))) bf16x8*)(kp);      kf[1]=*(const __attribute__((address_space(3))) bf16x8*)(kp+512);
  kf[2]=*(const __attribute__((address_space(3))) bf16x8*)(kp+2048); kf[3]=*(const __attribute__((address_space(3))) bf16x8*)(kp+2560);
  kf[4]=*(const __attribute__((address_space(3))) bf16x8*)(kp+4096); kf[5]=*(const __attribute__((address_space(3))) bf16x8*)(kp+4608);
  kf[6]=*(const __attribute__((address_space(3))) bf16x8*)(kp+6144); kf[7]=*(const __attribute__((address_space(3))) bf16x8*)(kp+6656);
}
__device__ __forceinline__ void kload2(bf16x8*kf,lds_cptr kp,int j){ kf[2*j]=*(const __attribute__((address_space(3))) bf16x8*)(kp+j*2048); kf[2*j+1]=*(const __attribute__((address_space(3))) bf16x8*)(kp+j*2048+512); }
__device__ __forceinline__ s16x4 vtr(lds_cptr p){ return __builtin_bit_cast(s16x4,__builtin_amdgcn_ds_read_tr16_b64_v4i16((__attribute__((address_space(3))) v4i16_t*)p)); }
__device__ __forceinline__ float rowmax(const f32x16&p0,const f32x16&p1){
  float a=max3f(p0[0],p0[1],p1[0]),b=max3f(p0[2],p0[3],p1[1]);a=max3f(a,p1[2],p1[3]);
  #pragma unroll
  for(int r=4;r<16;r+=4){a=max3f(a,p0[r],p0[r+1]);b=max3f(b,p0[r+2],p0[r+3]);a=max3f(a,p1[r],p1[r+1]);b=max3f(b,p1[r+2],p1[r+3]);}
  const float m=max2f(a,b);
  auto rr=__builtin_amdgcn_permlane32_swap(__float_as_uint(m),__float_as_uint(m),false,false);
  return max2f(__uint_as_float(rr[0]),__uint_as_float(rr[1]));
}
__device__ __forceinline__ void pv(f32x16*o,int vb,bf16x8 pa0,bf16x8 pa1,bf16x8 pa2,bf16x8 pa3){
  #pragma unroll
  for(int d0=0;d0<2;++d0){s16x4 lo[4],hi[4];
    #pragma unroll
    for(int ks=0;ks<4;++ks){
      asm volatile("ds_read_b64_tr_b16 %0,%1 offset:%c2":"=&v"(lo[ks]):"v"(vb),"i"(d0*4096+ks*1024):"memory");
      asm volatile("ds_read_b64_tr_b16 %0,%1 offset:%c2":"=&v"(hi[ks]):"v"(vb),"i"(d0*4096+ks*1024+512):"memory");}
    asm volatile("s_waitcnt lgkmcnt(0)":::"memory");SBAR();
    #define PK(k) (bf16x8){lo[k][0],lo[k][1],lo[k][2],lo[k][3],hi[k][0],hi[k][1],hi[k][2],hi[k][3]}
    o[d0]=__builtin_amdgcn_mfma_f32_32x32x16_bf16(pa0,PK(0),o[d0],0,0,0);
    o[d0]=__builtin_amdgcn_mfma_f32_32x32x16_bf16(pa1,PK(1),o[d0],0,0,0);
    o[d0]=__builtin_amdgcn_mfma_f32_32x32x16_bf16(pa2,PK(2),o[d0],0,0,0);
    o[d0]=__builtin_amdgcn_mfma_f32_32x32x16_bf16(pa3,PK(3),o[d0],0,0,0);
    #undef PK
  }
}

#ifndef ATTN_STORE16
#define ATTN_STORE16(p,v) (*(u32x4*)(p)=(v))
#endif
template<int THRL> __device__ __forceinline__ void attn_unit(int b,int h,int qb,const bf16*Q,const bf16*__restrict__ K,const bf16*__restrict__ V,bf16*O,const float*__restrict__ kmean,char*shm){
  const int tid=threadIdx.x,lane=tid&63,r32=lane&31,hi=lane>>5; const int wid=__builtin_amdgcn_readfirstlane(tid>>6);
  const long rowbase=(long)b*SEQ; const int q0=qb*QB;
  const bf16*Qw=Q+(rowbase+q0+wid*QBLK)*DM+h*D;
  const bf16*Kh=K+rowbase*DM+h*D,*Vh=V+rowbase*DM+h*D;
  const unsigned lds0=(unsigned)(uintptr_t)shm;
  float*wsf=(float*)(shm+LDS_WS)+wid*64;
  const bf16*ksrc=Kh+(long)lane*DM+wid*8;
  const bf16*vsrc=Vh+(long)(16*(wid&3)+(lane>>2))*DM+(wid>>2)*32+(lane&3)*8;
  const unsigned kdst=lds0+LDS_K+wid*1024, vdst=lds0+LDS_V+wid*1024;
  #define DMA_K(t,slot) glds16(ksrc+(long)(t)*KVBLK*DM,(unsigned)__builtin_amdgcn_readfirstlane(kdst+(slot)))
  #define DMA_V(t,slot) glds16(vsrc+(long)(t)*KVBLK*DM,(unsigned)__builtin_amdgcn_readfirstlane(vdst+(slot)))
  const int vb0=(int)(lds0+LDS_V)+((lane>>4)&1)*32+(lane&3)*8+(4*hi+((lane&15)>>2))*64;
  const char*Kbase=shm+LDS_K; bf16x8 kf[8];
  const lds_cptr shm3=(lds_cptr)shm; const lds_cptr kp0=shm3+LDS_K+hi*1024+r32*16; const lds_cptr vp0=shm3+LDS_V+((lane>>4)&1)*32+(lane&3)*8+(4*hi+((lane&15)>>2))*64;
  const int NT=(q0+QB)/KVBLK;
  DMA_K(0,0);DMA_V(0,0);DMA_K(1,SLOTB);
  bf16x8 qr[4];
  #pragma unroll
  for(int d0=0;d0<4;++d0)qr[d0]=*reinterpret_cast<const bf16x8*>(&Qw[(long)r32*DM+d0*16+hi*8]);
  unsigned selmask=0u;
  if(qb>0){
    f32x16 g=f32x16{};
    const float*kmrow=kmean+((long)(b*32+r32)*NHEAD+h)*D+hi*8;
    #pragma unroll
    for(int d0=0;d0<4;++d0){
      const f32x4_t a=*reinterpret_cast<const f32x4_t*>(kmrow+d0*16),c=*reinterpret_cast<const f32x4_t*>(kmrow+d0*16+4);
      u32x4 hw,lw; float hf[8],x[8]={a[0],a[1],a[2],a[3],c[0],c[1],c[2],c[3]};
      hw[0]=cvtpk_s(x[0],x[1]);hw[1]=cvtpk_s(x[2],x[3]);hw[2]=cvtpk_s(x[4],x[5]);hw[3]=cvtpk_s(x[6],x[7]);
      #pragma unroll
      for(int j=0;j<8;++j)hf[j]=__uint_as_float((j&1)?(hw[j>>1]&0xffff0000u):(hw[j>>1]<<16));
      lw[0]=cvtpk_s(x[0]-hf[0],x[1]-hf[1]);lw[1]=cvtpk_s(x[2]-hf[2],x[3]-hf[3]);lw[2]=cvtpk_s(x[4]-hf[4],x[5]-hf[5]);lw[3]=cvtpk_s(x[6]-hf[6],x[7]-hf[7]);
      g=__builtin_amdgcn_mfma_f32_32x32x16_bf16(__builtin_bit_cast(bf16x8,hw),qr[d0],g,0,0,0);
      g=__builtin_amdgcn_mfma_f32_32x32x16_bf16(__builtin_bit_cast(bf16x8,lw),qr[d0],g,0,0,0);}
    float b1=-INFINITY,b2=-INFINITY,b3=-INFINITY;int i1=99,i2=99,i3=99;
    #define INS(x_,n_) do{const float xx_=(x_);const int nn_=(n_); const bool c1=(xx_>b1)||(xx_==b1&&nn_<i1),c2=(xx_>b2)||(xx_==b2&&nn_<i2),c3=(xx_>b3)||(xx_==b3&&nn_<i3); \
      b3=c2?b2:(c3?xx_:b3); i3=c2?i2:(c3?nn_:i3); b2=c1?b1:(c2?xx_:b2); i2=c1?i1:(c2?nn_:i2); b1=c1?xx_:b1; i1=c1?nn_:i1; }while(0)
    #pragma unroll
    for(int r=0;r<16;++r){const int n=crow(r,hi); const float x=(n<qb)?g[r]:-INFINITY; INS(x,n);}
    { const float p1=__shfl_xor(b1,32),p2=__shfl_xor(b2,32),p3=__shfl_xor(b3,32); const int j1=__shfl_xor(i1,32),j2=__shfl_xor(i2,32),j3=__shfl_xor(i3,32);
      INS(p1,j1);INS(p2,j2);INS(p3,j3); }
    #undef INS
    if(b1>-INFINITY)selmask|=1u<<i1; if(b2>-INFINITY)selmask|=1u<<i2; if(b3>-INFINITY)selmask|=1u<<i3;
  }
  #define SELT(t) (((t)>=NT-4)||((selmask>>((t)>>2))&1u))
  float mhat=0.f,l_reg=0.f;f32x16 o[2];o[0]=f32x16{};o[1]=f32x16{};f32x16 negm;
  { const float nv_=SELT(0)?0.f:-INFINITY; _Pragma("unroll") for(int r=0;r<16;++r)negm[r]=nv_; } asm volatile("":"+v"(negm));
  const int qrel=wid*QBLK+r32;
  #define CMASK(P0,P1,t) do{int jb_=(t)-(NT-4); if(jb_>=0)cmask(P0,P1,jb_,qrel,hi);}while(0)
  bool resc=false;
  #define START(P0,P1) do{ const float rm=rowmax(P0,P1); resc=false; \
    { const float dl=max2f(rm,-64.f); mhat=fadd_s(mhat,dl); \
      _Pragma("unroll") for(int r=0;r<16;++r){P0[r]=fsub_s(P0[r],dl);P1[r]=fsub_s(P1[r],dl);} \
      _Pragma("unroll") for(int r=0;r<16;++r)negm[r]=-mhat; asm volatile("":"+v"(negm)); } \
    _Pragma("unroll") for(int r=0;r<16;++r)P0[r]=__builtin_amdgcn_exp2f(P0[r]); }while(0)
  #define RESC() do{ if(resc){ asm volatile("s_waitcnt lgkmcnt(0)":::"memory"); \
      _Pragma("unroll") for(int d_=0;d_<2;++d_) _Pragma("unroll") for(int r=0;r<16;++r)o[d_][r]*=wsf[crow(r,hi)]; } }while(0)
  f32x16 pA0,pA1,pB0,pB1;
  int sl_prev=0,sl_cur=0,sl_next=SLOTB;
  #define ROT() do{sl_prev=sl_cur;sl_cur=sl_next;sl_next=(sl_next==(NSLOT-1)*SLOTB)?0:sl_next+SLOTB;}while(0)
  DMA_K(2,2*SLOTB);
  WAIT_BAR(3);
  qkt(pA0,pA1,Kbase,qr,negm,r32,hi);asm volatile("s_nop 15\n\ts_nop 7":"+v"(pA0),"+v"(pA1));CMASK(pA0,pA1,0);
  START(pA0,pA1);
  _Pragma("unroll") for(int r=0;r<16;++r)pA1[r]=__builtin_amdgcn_exp2f(pA1[r]);
  WAIT_BAR(0);
  DMA_K(3,0);DMA_V(1,SLOTB);
  ROT();
  kload8(kf,kp0+sl_cur);
  WAIT_BAR(2);
  s16x4 vlo[8],vhi[8]; u32x4 pw0,pw1,pw2,pw3;
  #define PKW(P,B) cvtpk_s(P[B],P[B+1])
  #define PAF(k) __builtin_bit_cast(bf16x8,pw##k)
  #define VFR(i) (bf16x8){vlo[i][0],vlo[i][1],vlo[i][2],vlo[i][3],vhi[i][0],vhi[i][1],vhi[i][2],vhi[i][3]}
  #define PIN(x) asm volatile("":"+v"(x))
  #define MX3(a,b,c) __builtin_fmaxf(__builtin_fmaxf((a),(b)),(c))
  #define GAPA(MF,A0,A1,A2,A3,W0,W1,PW) do{ MF; sacc+=A0; sacc+=A1; sacc+=A2; sacc+=A3; PIN(sacc); W0; W1; PIN(PW); SBAR(); }while(0)
  #define EX(v) __builtin_amdgcn_exp2f(v)
  #define GAPB(MF,X,B) do{ MF; X[B]=EX(X[B]); X[B+1]=EX(X[B+1]); X[B+2]=EX(X[B+2]); X[B+3]=EX(X[B+3]); PIN(X); SBAR(); }while(0)
  #define VRD(i) do{ vlo[i]=vtr(vp_+(((i)>>2)*4096+((i)&3)*1024)); vhi[i]=vtr(vp_+(((i)>>2)*4096+((i)&3)*1024+512)); }while(0)
  #define KRD(G,j) do{ if(G){ kload2(kf,kp0+sl_next,j); SBAR(); } }while(0)
  #define STEP(C0,C1,P0,P1,t,GK,GV,GL) do{ SBAR(); \
    { const float nv_=SELT(t)?-mhat:-INFINITY; _Pragma("unroll") for(int r=0;r<16;++r)negm[r]=nv_; asm volatile("":"+v"(negm)); } \
    const lds_cptr vp_=vp0+sl_prev; \
    VRD(0); SBAR(); float sacc=(P0[0]+P0[1]); \
    GAPA(C0=__builtin_amdgcn_mfma_f32_32x32x16_bf16(kf[0],qr[0],negm,0,0,0), P0[2],P0[3],P0[4],P0[5],     pw0[0]=PKW(P0,0), pw0[1]=PKW(P0,2), pw0); \
    VRD(4); SBAR(); GAPA(C1=__builtin_amdgcn_mfma_f32_32x32x16_bf16(kf[1],qr[0],negm,0,0,0), P0[6],P0[7],P0[8],P0[9],     pw0[2]=PKW(P0,4), pw0[3]=PKW(P0,6), pw0); \
    VRD(1); SBAR(); GAPA(C0=__builtin_amdgcn_mfma_f32_32x32x16_bf16(kf[2],qr[1],C0,0,0,0),   P0[10],P0[11],P0[12],P0[13], pw1[0]=PKW(P0,8), pw1[1]=PKW(P0,10), pw1); \
    VRD(5); SBAR(); GAPA(C1=__builtin_amdgcn_mfma_f32_32x32x16_bf16(kf[3],qr[1],C1,0,0,0),   P0[14],P0[15],P1[0],P1[1],   pw1[2]=PKW(P0,12),pw1[3]=PKW(P0,14), pw1); \
    VRD(2); SBAR(); GAPA(C0=__builtin_amdgcn_mfma_f32_32x32x16_bf16(kf[4],qr[2],C0,0,0,0),   P1[2],P1[3],P1[4],P1[5],     pw2[0]=PKW(P1,0), pw2[1]=PKW(P1,2), pw2); \
    VRD(6); SBAR(); GAPA(C1=__builtin_amdgcn_mfma_f32_32x32x16_bf16(kf[5],qr[2],C1,0,0,0),   P1[6],P1[7],P1[8],P1[9],     pw2[2]=PKW(P1,4), pw2[3]=PKW(P1,6), pw2); \
    VRD(3); SBAR(); GAPA(C0=__builtin_amdgcn_mfma_f32_32x32x16_bf16(kf[6],qr[3],C0,0,0,0),   P1[10],P1[11],P1[12],P1[13], pw3[0]=PKW(P1,8), pw3[1]=PKW(P1,10), pw3); \
    VRD(7); SBAR(); GAPA(C1=__builtin_amdgcn_mfma_f32_32x32x16_bf16(kf[7],qr[3],C1,0,0,0),   P1[14],P1[15],0.f,0.f,       pw3[2]=PKW(P1,12),pw3[3]=PKW(P1,14), pw3); \
    l_reg+=sacc; \
    if(GK){DMA_K((t)+3,sl_cur);} if(GV){DMA_V((t)+1,sl_next);} \
    CMASK(C0,C1,t); \
    { float a=MX3(C0[0],C0[1],C1[0]),b=MX3(C0[2],C0[3],C1[1]); a=MX3(a,C1[2],C1[3]); \
      _Pragma("unroll") for(int r=4;r<16;r+=4){a=MX3(a,C0[r],C0[r+1]);b=MX3(b,C0[r+2],C0[r+3]);a=MX3(a,C1[r],C1[r+1]);b=MX3(b,C1[r+2],C1[r+3]);} \
      float rm=__builtin_fmaxf(a,b); { auto rr=__builtin_amdgcn_permlane32_swap(__float_as_uint(rm),__float_as_uint(rm),false,false); rm=__builtin_fmaxf(__uint_as_float(rr[0]),__uint_as_float(rr[1])); } \
      resc=false; \
      if(__builtin_expect(__any(rm>(float)THRL),0)){ const float dl=__builtin_fmaxf(rm,0.f); mhat+=dl; \
        _Pragma("unroll") for(int r=0;r<16;++r){C0[r]-=dl;C1[r]-=dl;} \
        const float f=__builtin_amdgcn_exp2f(-dl); l_reg*=f; if(hi==0)wsf[r32]=f; resc=true; } } \
    SBAR(); \
    GAPB(o[0]=__builtin_amdgcn_mfma_f32_32x32x16_bf16(PAF(0),VFR(0),o[0],0,0,0), C0,0); \
    GAPB(o[1]=__builtin_amdgcn_mfma_f32_32x32x16_bf16(PAF(0),VFR(4),o[1],0,0,0), C0,4); \
    KRD(GL,0); GAPB(o[0]=__builtin_amdgcn_mfma_f32_32x32x16_bf16(PAF(1),VFR(1),o[0],0,0,0), C0,8); \
    KRD(GL,1); GAPB(o[1]=__builtin_amdgcn_mfma_f32_32x32x16_bf16(PAF(1),VFR(5),o[1],0,0,0), C0,12); \
    KRD(GL,2); GAPB(o[0]=__builtin_amdgcn_mfma_f32_32x32x16_bf16(PAF(2),VFR(2),o[0],0,0,0), C1,0); \
    KRD(GL,3); GAPB(o[1]=__builtin_amdgcn_mfma_f32_32x32x16_bf16(PAF(2),VFR(6),o[1],0,0,0), C1,4); \
    GAPB(o[0]=__builtin_amdgcn_mfma_f32_32x32x16_bf16(PAF(3),VFR(3),o[0],0,0,0), C1,8); \
    GAPB(o[1]=__builtin_amdgcn_mfma_f32_32x32x16_bf16(PAF(3),VFR(7),o[1],0,0,0), C1,12); \
    }while(0)
  int t=1;
  #undef CMASK
  #define CMASK(P0,P1,t) do{}while(0)
  for(;t+5<NT;t+=2){
    STEP(pB0,pB1,pA0,pA1,t,true,true,true);     WAIT_BAR(2); RESC(); ROT();
    STEP(pA0,pA1,pB0,pB1,t+1,true,true,true);   WAIT_BAR(2); RESC(); ROT();
  }
  #undef CMASK
  #define CMASK(P0,P1,t) do{int jb_=(t)-(NT-4); if(jb_>=0)cmask(P0,P1,jb_,qrel,hi);}while(0)
  #define ENDW(tt) do{ if((tt)+3<NT){WAIT_BAR(2);} else if((tt)+2<NT){WAIT_BAR(1);} else {WAIT_BAR(0);} }while(0)
  for(;t+1<NT;t+=2){
    STEP(pB0,pB1,pA0,pA1,t,(t+3<NT),(t+1<NT),(t+1<NT));       ENDW(t);   RESC(); ROT();
    STEP(pA0,pA1,pB0,pB1,t+1,(t+4<NT),(t+2<NT),(t+2<NT));     ENDW(t+1); RESC(); ROT();
  }
  STEP(pB0,pB1,pA0,pA1,NT-1,false,false,false); RESC();
  { float sacc=pB0[0]+pB0[1]; _Pragma("unroll") for(int r=2;r<16;++r)sacc+=pB0[r]; _Pragma("unroll") for(int r=0;r<16;++r)sacc+=pB1[r]; l_reg+=sacc;
    pw0=(u32x4){PKW(pB0,0),PKW(pB0,2),PKW(pB0,4),PKW(pB0,6)};pw1=(u32x4){PKW(pB0,8),PKW(pB0,10),PKW(pB0,12),PKW(pB0,14)};pw2=(u32x4){PKW(pB1,0),PKW(pB1,2),PKW(pB1,4),PKW(pB1,6)};pw3=(u32x4){PKW(pB1,8),PKW(pB1,10),PKW(pB1,12),PKW(pB1,14)};
    SBAR(); pv(o,vb0+sl_cur,PAF(0),PAF(1),PAF(2),PAF(3)); }
  #undef PKW
  #undef PAF
  #undef VFR
  #undef PIN
  #undef MX3
  #undef GAPA
  #undef GAPB
  #undef EX
  #undef VRD
  #undef KRD
  #undef STEP
  #undef ENDW
  {auto rr=__builtin_amdgcn_permlane32_swap(__float_as_uint(l_reg),__float_as_uint(l_reg),false,false);l_reg=__uint_as_float(rr[0])+__uint_as_float(rr[1]);}
  if(hi==0)wsf[32+r32]=l_reg;asm volatile("s_waitcnt lgkmcnt(0)":::"memory");
  float rli[16];
  #pragma unroll
  for(int r=0;r<16;++r)rli[r]=__builtin_amdgcn_rcpf(wsf[32+crow(r,hi)]);
  bf16*Ow=O+(rowbase+q0+wid*QBLK)*OPITCH+h*D;
  { bf16*stg=(bf16*)(shm+LDS_OST)+wid*2048;
    #pragma unroll
    for(int r=0;r<16;++r){const int orow=crow(r,hi);
      #pragma unroll
      for(int d0=0;d0<2;++d0)stg[orow*64+d0*32+r32]=__float2bfloat16(o[d0][r]*rli[r]);}
    asm volatile("s_waitcnt lgkmcnt(0)":::"memory");
    #pragma unroll
    for(int i=0;i<4;++i){const int row=i*8+(lane>>3),ch=lane&7; const u32x4 v=*(const u32x4*)(stg+row*64+ch*8); ATTN_STORE16(Ow+(long)row*OPITCH+ch*8,v);} }
  asm volatile("s_waitcnt lgkmcnt(0)\n\ts_barrier":::"memory");
  #undef DMA_K
  #undef DMA_V
  #undef CMASK
  #undef START
  #undef RESC
  #undef ROT
  #undef SELT
}
constexpr int ATTN_LDS_BYTES=LDS_BYTES;
struct AttnTensors { const bf16* Q; const bf16* K; const bf16* V; bf16* O; const float* kmean; };
struct AttnUnit { int bh; int qb; };
struct StaticOrder {
  int vcu,G;
  __device__ __forceinline__ explicit StaticOrder(int grid,int block):vcu((grid%8==0)?(block%8)*(grid/8)+block/8:block),G(grid){}
  __device__ __forceinline__ bool next(int i,AttnUnit&u)const{ const int slot=vcu+(i>>1)*G; if(slot>=256)return false; const int s=slot&15; u.bh=slot>>4; u.qb=(i&1)?31-s:s; return true; }
  __device__ __forceinline__ void a_ready(const AttnUnit&)const{}
  __device__ __forceinline__ void done(const AttnUnit&)const{}
};
template<class Sched,int THRL=8> __device__ __forceinline__ void attn_phase(char*lds,const AttnTensors&T,const Sched&S){
  AttnUnit u;
  for(int i=0;S.next(i,u);++i){ S.a_ready(u); attn_unit<THRL>(u.bh/NHEAD,u.bh%NHEAD,u.qb,T.Q,T.K,T.V,T.O,T.kmean,lds); S.done(u); }
}
#undef SBAR
#undef WAIT_BAR
}

constexpr int NWAVES = 8;
constexpr size_t MiB = 1u << 20;
constexpr size_t WS_CTL = 0, CTL_ZERO_BYTES = 1 * MiB;
constexpr size_t WS_WIN = 2 * MiB, WS_WOUT = 9 * MiB, WS_WUP = 11 * MiB, WS_WDOWN = 22 * MiB;
constexpr size_t WS_ROPE = 28 * MiB, WS_KMEAN = 30 * MiB, WS_SSQA = 31 * MiB, WS_SSQB = 32 * MiB;
constexpr size_t WS_XN = 34 * MiB + 65536;
constexpr size_t WS_Q = 68 * MiB, WS_K = 84 * MiB, WS_V = 100 * MiB, WS_GQ = 116 * MiB, WS_GK = 124 * MiB, WS_GV = 132 * MiB, WS_SR = 148 * MiB, WS_LOGA = 164 * MiB, WS_ADEC = 180 * MiB;
constexpr size_t WS_YMIX = 196 * MiB;
constexpr size_t WS_ACT = 68 * MiB;
constexpr size_t WS_END = 256 * MiB;
constexpr int CW_BAR = 4096;

constexpr int RING_OFF = 0, RING_BYTES = 131072;
constexpr int LDSCTL_OFF = RING_BYTES, MISC_OFF = LDSCTL_OFF + 320;
constexpr int LDS_BYTES = 147456;

#define GAS __attribute__((address_space(1)))
#define LAS __attribute__((address_space(3)))
typedef unsigned v4u __attribute__((ext_vector_type(4)));
typedef float f32x4 __attribute__((ext_vector_type(4)));
typedef GAS unsigned gu32;
#define RLX_AGENT __ATOMIC_RELAXED, __HIP_MEMORY_SCOPE_AGENT
#define LDS_WAIT() asm volatile("s_waitcnt lgkmcnt(0)" ::: "memory")
#define VM_WAIT() asm volatile("s_waitcnt vmcnt(0)" ::: "memory")
__device__ __forceinline__ unsigned pk2(float lo, float hi) { return f2bf(lo) | (f2bf(hi) << 16); }
#define XB_TMO      128
#define XB_XCNT(j)  (256  + 64 * (j))
#define XB_XSUB(j)  (1280 + 64 * (j))
#define XB_XGEN(j)  (2304 + 64 * (j))
#define XB_TOP      3328
#define XB_TOPGEN   3392
#define XCD_BAR_WORDS 3456
#define XB_SPIN_CAP (1u << 18)

__device__ __forceinline__ unsigned xb_ld(unsigned* p)              { return __hip_atomic_load(p, __ATOMIC_RELAXED, __HIP_MEMORY_SCOPE_AGENT); }
__device__ __forceinline__ unsigned xb_add(unsigned* p, unsigned v) { return __hip_atomic_fetch_add(p, v, __ATOMIC_RELAXED, __HIP_MEMORY_SCOPE_AGENT); }
__device__ __forceinline__ unsigned xb_xcc_id() { return (unsigned)__builtin_amdgcn_s_getreg((3 << 11) | 20) & 0xFu; }
#define XB_SPIN(cond, bar) do { unsigned _sp = 0; while (cond) { __builtin_amdgcn_s_sleep(1); \
    if ((++_sp & 255u) == 0u) { if (xb_ld(&(bar)[XB_TMO])) break; if (_sp > XB_SPIN_CAP) { atomicAdd(&(bar)[XB_TMO], 1u); break; } } } } while (0)

struct XcdBarrier {
    unsigned* bar; unsigned x;
    volatile LAS unsigned* st;
};

__device__ __forceinline__ XcdBarrier xcd_barrier_post(unsigned* bar, volatile LAS unsigned* st) {
    XcdBarrier b; b.bar = bar; b.x = xb_xcc_id(); b.st = st;
    if (threadIdx.x == 0) (void)xb_add(&bar[XB_XCNT(b.x)], 1u);
    return b;
}
__device__ __forceinline__ void xcd_barrier_complete(unsigned* bar, unsigned x, unsigned& nloc, unsigned& nx) {
    const unsigned G = gridDim.x * gridDim.y * gridDim.z;
    unsigned sum, cnt, mine, sp = 0u;
    for (;;) {
        sum = 0u; cnt = 0u; mine = 0u;
#pragma unroll
        for (unsigned j = 0; j < 16; ++j) { const unsigned c = xb_ld(&bar[XB_XCNT(j)]); sum += c; cnt += (c > 0u) ? 1u : 0u; mine = (j == x) ? c : mine; }
        if (sum == G) break;
        __builtin_amdgcn_s_sleep(1);
        if ((++sp & 255u) == 0u) { if (xb_ld(&bar[XB_TMO])) break; if (sp > XB_SPIN_CAP) { atomicAdd(&bar[XB_TMO], 1u); break; } }
    }
    nloc = mine > 0u ? mine : 1u; nx = cnt > 0u ? cnt : 1u;
}

__device__ __forceinline__ void xcd_barrier(const XcdBarrier& b) {
    asm volatile("s_waitcnt vmcnt(0)" ::: "memory");
    __syncthreads();
    if (threadIdx.x == 0) {
        unsigned* bar = b.bar;
        __builtin_amdgcn_s_waitcnt(0);
        unsigned nloc = b.st[0], nx = b.st[1];
        if (nloc == 0u) { xcd_barrier_complete(bar, b.x, nloc, nx); b.st[0] = nloc; b.st[1] = nx; }
        const unsigned old = xb_add(&bar[XB_XSUB(b.x)], 1u);
        const unsigned gen = old / nloc;
        if (old + 1u == (gen + 1u) * nloc) {
            __builtin_amdgcn_fence(__ATOMIC_RELEASE, "agent");
            asm volatile("s_waitcnt vmcnt(0)" ::: "memory");
            const unsigned og = xb_add(&bar[XB_TOP], 1u);
            const unsigned tg = og / nx;
            if (og + 1u == (tg + 1u) * nx) xb_add(&bar[XB_TOPGEN], 1u);
            else XB_SPIN(xb_ld(&bar[XB_TOPGEN]) == tg, bar);
            __builtin_amdgcn_fence(__ATOMIC_ACQUIRE, "agent");
            xb_add(&bar[XB_XGEN(b.x)], 1u);
            asm volatile("s_waitcnt vmcnt(0)" ::: "memory");
        } else {
            XB_SPIN(xb_ld(&bar[XB_XGEN(b.x)]) == gen, bar);
            __builtin_amdgcn_fence(__ATOMIC_ACQUIRE, "agent");
            asm volatile("s_waitcnt vmcnt(0)" ::: "memory");
        }
    }
    __syncthreads();
}

struct Frame {
    LAS unsigned char* lds; volatile LAS unsigned* MISC; gu32* ctl;
    int tid, lane, wave, vcu, G;
};
template <int CMAP> __device__ __forceinline__ int col_map(int n) {
    if (CMAP == 1) { return (n < 1024) ? ((n & ~63) + ((n & 1) << 5) + ((n & 63) >> 1)) : n; }
    if (CMAP == 2) { const int pn = n >> 8, jj = n & 255; return (jj < 128) ? (pn * 128 + jj) : (DFF + pn * 128 + (jj - 128)); }
    return n;
}
template <int CMAP> __device__ __forceinline__ void p0_transpose_item(const float* W, int K, int ldw, int Nout, bf16_t* WT, LAS float* scr, int item, int lane) {
    const int nblk = Nout / 32, kb = item / nblk, nb = item % nblk, k0 = 64 * kb, n0 = 32 * nb;
    const int sc = col_map<CMAP>(n0 + (lane & 31));
#pragma unroll 8
    for (int i = 0; i < 32; ++i) { const int kk = 2 * i + (lane >> 5); scr[kk * 33 + (lane & 31)] = W[(size_t)(k0 + kk) * ldw + sc]; }
    LDS_WAIT(); asm volatile("" ::: "memory");
    const int c = lane & 7;
#pragma unroll
    for (int j = 0; j < 4; ++j) { const int n = (lane >> 3) + 8 * j; const LAS float* s = scr + (8 * c) * 33 + n;
        v4u o; o.x = pk2(s[0 * 33], s[1 * 33]); o.y = pk2(s[2 * 33], s[3 * 33]); o.z = pk2(s[4 * 33], s[5 * 33]); o.w = pk2(s[6 * 33], s[7 * 33]);
        *(GAS v4u*)(WT + (size_t)(n0 + n) * K + k0 + 8 * c) = o; }
    LDS_WAIT(); asm volatile("" ::: "memory");
}

struct Args { const float* in[13]; float* out; unsigned char* ws; int ph_lo, ph_hi, li, pad; };

__device__ __forceinline__ void p0_prologue(Frame& F, const Args& a) {
    unsigned char* ws = a.ws;
    LAS float* scr = (LAS float*)(F.lds + RING_OFF + F.wave * 16384);
    const int gw = F.vcu * NWAVES + F.wave, NGW = F.G * NWAVES;
    const float* w_in = a.in[2]; const float* w_gate_up = a.in[3]; const float* w_out = a.in[6]; const float* w_up = a.in[8]; const float* w_down = a.in[11];
    bf16_t* WIN = (bf16_t*)(ws + WS_WIN); bf16_t* WOUT = (bf16_t*)(ws + WS_WOUT); bf16_t* WUP = (bf16_t*)(ws + WS_WUP); bf16_t* WDOWN = (bf16_t*)(ws + WS_WDOWN);
    constexpr int I_IN = (DM / 64) * (3072 / 32), I_OUT = (DM / 64) * (DM / 32), I_UP = (DM / 64) * (NUP / 32), I_DOWN = (DFF / 64) * (DM / 32);
    constexpr int NITEMS = I_IN + I_OUT + I_UP + I_DOWN;
    for (int it = gw; it < NITEMS; it += NGW) {
        int r = it;
        if (r < I_IN) { p0_transpose_item<1>(w_in, DM, NIN, 3072, WIN, scr, r, F.lane); continue; } r -= I_IN;
        if (r < I_OUT) { p0_transpose_item<0>(w_out, DM, DM, DM, WOUT, scr, r, F.lane); continue; } r -= I_OUT;
        if (r < I_UP) { p0_transpose_item<2>(w_up, DM, NUP, NUP, WUP, scr, r, F.lane); continue; } r -= I_UP;
        p0_transpose_item<0>(w_down, DFF, DM, DM, WDOWN, scr, r, F.lane);
    }
    const int gt = gw * 64 + F.lane, NGT = NGW * 64;
    for (int idx = gt; idx < 256 * 128; idx += NGT) { const int c = idx & 255, k0 = (idx >> 8) * 8; float wg[16];
#pragma unroll
        for (int r = 0; r < 16; ++r) wg[r] = w_gate_up[r * 256 + c];
        float o[8];
#pragma unroll
        for (int e = 0; e < 8; ++e) { const f32x4* wp = (const f32x4*)(w_in + (size_t)(k0 + e) * NIN + 3072); float s = 0.f;
#pragma unroll
            for (int r4 = 0; r4 < 4; ++r4) { const f32x4 w4 = wp[r4]; s += w4[0] * wg[4 * r4] + w4[1] * wg[4 * r4 + 1] + w4[2] * wg[4 * r4 + 2] + w4[3] * wg[4 * r4 + 3]; }
            o[e] = s; }
        v4u w; w.x = pk2(o[0], o[1]); w.y = pk2(o[2], o[3]); w.z = pk2(o[4], o[5]); w.w = pk2(o[6], o[7]);
        *(GAS v4u*)(WIN + (size_t)(3072 + c) * DM + k0) = w; }
    { float2* tab = (float2*)(ws + WS_ROPE);
      for (int idx = gt; idx < SEQ * 32; idx += NGT) { const int pos = idx >> 5, i = idx & 31; const double rev = (double)pos * INV_FREQ[i] * 0.15915494309189535; const float f = (float)(rev - __builtin_rint(rev));
          tab[idx] = make_float2(__builtin_amdgcn_cosf(f), __builtin_amdgcn_sinf(f)); } }
    { float* km = (float*)(ws + WS_KMEAN); for (int idx = gt; idx < NB * 32 * 512; idx += NGT) km[idx] = 0.f; }
    { const float* x = a.in[0]; const float* g = a.in[1]; bf16_t* XN = (bf16_t*)(ws + WS_XN);
      for (int m = gw; m < M; m += NGW) { const GAS f32x4* xr = (const GAS f32x4*)(x + (size_t)m * DM) + F.lane; f32x4 v[4]; float s = 0.f;
#pragma unroll
          for (int j = 0; j < 4; ++j) { v[j] = xr[64 * j]; s += (v[j].x * v[j].x + v[j].y * v[j].y) + (v[j].z * v[j].z + v[j].w * v[j].w); }
          const float rstd = 1.f / sqrtf(wave_sum(s) * (1.f / DM) + EPS);
          GAS unsigned long long* o8 = (GAS unsigned long long*)(XN + (size_t)m * DM) + F.lane;
#pragma unroll
          for (int j = 0; j < 4; ++j) { const f32x4 gg = ((const GAS f32x4*)g)[64 * j + F.lane];
              o8[64 * j] = (unsigned long long)pk2(v[j].x * rstd * gg.x, v[j].y * rstd * gg.y) | ((unsigned long long)pk2(v[j].z * rstd * gg.z, v[j].w * rstd * gg.w) << 32); } } }
}
__device__ __forceinline__ void p_final(Frame& F, const Args& a) {
    const int gw = F.vcu * NWAVES + F.wave, NGW = F.G * NWAVES; const float* g = a.in[12]; const float* ssq = (const float*)(a.ws + WS_SSQB);
    for (int m = gw; m < M; m += NGW) { GAS f32x4* yr = (GAS f32x4*)(a.out + (size_t)m * DM) + F.lane;
        const float p = (F.lane < 16) ? ssq[(size_t)m * 16 + F.lane] : 0.f; const float rstd = 1.f / sqrtf(wave_sum(p) * (1.f / DM) + EPS);
#pragma unroll
        for (int j = 0; j < 4; ++j) { const f32x4 v = yr[64 * j]; const f32x4 gg = ((const GAS f32x4*)g)[64 * j + F.lane]; yr[64 * j] = v * rstd * gg; } }
}

__global__ void __launch_bounds__(NWAVES * 64, 2) skel_fwd(Args args) {
    extern __shared__ __attribute__((aligned(16))) unsigned char lds[];
    Frame F;
    F.lds = (LAS unsigned char*)lds; F.MISC = (volatile LAS unsigned*)(F.lds + MISC_OFF);
    F.tid = threadIdx.x; F.lane = F.tid & 63; F.wave = __builtin_amdgcn_readfirstlane(F.tid >> 6);
    F.G = gridDim.x; { const int bx = blockIdx.x; F.vcu = (F.G % 8 == 0) ? (bx % 8) * (F.G / 8) + bx / 8 : bx; }
    unsigned char* ws = args.ws; F.ctl = (gu32*)(ws + WS_CTL);
    for (int u = F.tid; u < (LDS_BYTES - LDSCTL_OFF) / 4; u += NWAVES * 64) ((LAS unsigned*)(F.lds + LDSCTL_OFF))[u] = 0u;
    __syncthreads();
    XcdBarrier bar = xcd_barrier_post((unsigned*)(F.ctl + CW_BAR) + args.li * XCD_BAR_WORDS, F.MISC + 8);
    const int lo = args.ph_lo, hi = args.ph_hi;
#define IN(k) (lo <= (k) && (k) < hi)
#define BOTH(k) (IN(k) && IN((k) + 1))
#define GRID_BAR() xcd_barrier(bar)
    bf16_t* XN = (bf16_t*)(ws + WS_XN);
    if (IN(0)) { p0_prologue(F, args); if (BOTH(0)) GRID_BAR(); }
    if (IN(1)) {
        pg8::Gemm g{XN, (const bf16_t*)(ws + WS_WIN), M, NINP, DM}; pg8::StaticOrder S; S.init(M / 256, NINP / 256, F.G, (int)blockIdx.x);
        pg8::EpiInProj E{(bf16_t*)(ws + WS_Q), (bf16_t*)(ws + WS_K), (bf16_t*)(ws + WS_V), (bf16_t*)(ws + WS_GQ), (bf16_t*)(ws + WS_GK), (bf16_t*)(ws + WS_GV), (bf16_t*)(ws + WS_SR),
                         (float*)(ws + WS_LOGA), (float*)(ws + WS_KMEAN), (const float*)(ws + WS_ROPE), args.in[4]};
        pg8::gemm_phase<pg8::EpiInProj, pg8::StaticOrder, pg8::AMapStd, true, true>(F.lds + RING_OFF, g, S, E);
        if (BOTH(1)) GRID_BAR();
    }
    if (IN(2)) {
        IF1 f; f.q = (bf16_t*)(ws + WS_Q); f.k = (bf16_t*)(ws + WS_K); f.v = (bf16_t*)(ws + WS_V); f.gq = (bf16_t*)(ws + WS_GQ); f.gk = (bf16_t*)(ws + WS_GK); f.gv = (bf16_t*)(ws + WS_GV);
        f.sr = (bf16_t*)(ws + WS_SR); f.loga = (float*)(ws + WS_LOGA); f.adec = (float*)(ws + WS_ADEC); f.kmean = (float*)(ws + WS_KMEAN); f.rope = (const float2*)(ws + WS_ROPE);
        bf16_t* ymix = (bf16_t*)(ws + WS_YMIX); float* oraw = args.out;
        const int gw = F.vcu * NWAVES + F.wave, NGW = F.G * NWAVES;
        for (int i = gw * 64 + F.lane; i < M * 256; i += NGW * 64) f.adec[i] = expf(f.loga[i]);
        { const attn_body::AttnTensors AT{(const attn_body::bf16*)f.q, (const attn_body::bf16*)f.k, (const attn_body::bf16*)f.v, (attn_body::bf16*)ymix, f.kmean};
          const attn_body::StaticOrder S((int)F.G, (int)blockIdx.x);
          attn_body::attn_phase<attn_body::StaticOrder>((char*)lds + RING_OFF, AT, S); }
        GRID_BAR();
        if (blockIdx.x < 8 && F.tid < 128) gla_rec_bh(f, oraw, (int)blockIdx.x, F.tid);
        GRID_BAR();
        for (int p = gw; p < M * 4; p += NGW) gla_norm_rh(oraw, args.in[5], f.sr, ymix, p >> 2, p & 3, F.lane);
        if (BOTH(2)) GRID_BAR();
    }
    if (IN(3)) {
        pg8::Gemm g{(const bf16_t*)(ws + WS_YMIX), (const bf16_t*)(ws + WS_WOUT), M, DM, DM}; pg8::StaticOrder S; S.init(M / 256, DM / 256, F.G, (int)blockIdx.x);
        pg8::EpiOutProj E{args.in[0], args.out, XN, args.in[7], (float*)(ws + WS_SSQA)};
        pg8::gemm_phase<pg8::EpiOutProj, pg8::StaticOrder, pg8::AMapStd, true, true>(F.lds + RING_OFF, g, S, E);
        if (BOTH(3)) GRID_BAR();
    }
    if (IN(4)) {
        pg8::Gemm g{XN, (const bf16_t*)(ws + WS_WUP), M, NUP, DM}; pg8::StaticOrder S; S.init(66, NUP / 256, F.G, (int)blockIdx.x);
        pg8::EpiUp E{(const float*)(ws + WS_SSQA), args.in[9], args.in[10], (bf16_t*)(ws + WS_ACT)};
        pg8::gemm_phase<pg8::EpiUp, pg8::StaticOrder, pg8::AMapConv, true, true>(F.lds + RING_OFF, g, S, E);
        if (BOTH(4)) GRID_BAR();
    }
    if (IN(5)) {
        pg8::Gemm g{(const bf16_t*)(ws + WS_ACT), (const bf16_t*)(ws + WS_WDOWN), M, DM, DFF}; pg8::StaticOrder S; S.init(M / 256, DM / 256, F.G, (int)blockIdx.x);
        pg8::EpiDown E{args.out, (float*)(ws + WS_SSQB)};
        pg8::gemm_phase<pg8::EpiDown, pg8::StaticOrder, pg8::AMapStd, true, true>(F.lds + RING_OFF, g, S, E);
        if (BOTH(5)) GRID_BAR();
    }
    if (IN(6)) { p_final(F, args); }
#undef IN
#undef BOTH
#undef GRID_BAR
}


extern "C" void kernel_launch(void* const* d_in, const int* in_sizes, int n_in, void* d_out, int out_size, void* d_ws, size_t ws_size, hipStream_t stream) {
    static int grid = 0;
    if (grid == 0) {
        if (n_in != 13 || in_sizes[0] != M * DM || out_size != M * DM || ws_size < WS_END) { fprintf(stderr, "kernel_launch: unexpected shapes / workspace (%d inputs, ws %zu)\n", n_in, ws_size); grid = -1; return; }
        int dev = 0, cus = 0, per_cu = 0;
        if (hipGetDevice(&dev) != hipSuccess || hipDeviceGetAttribute(&cus, hipDeviceAttributeMultiprocessorCount, dev) != hipSuccess) { grid = -1; return; }
        if (hipFuncSetAttribute((const void*)skel_fwd, hipFuncAttributeMaxDynamicSharedMemorySize, LDS_BYTES) != hipSuccess) { fprintf(stderr, "kernel_launch: hipFuncSetAttribute failed\n"); grid = -1; return; }
        if (hipOccupancyMaxActiveBlocksPerMultiprocessor(&per_cu, (const void*)skel_fwd, NWAVES * 64, LDS_BYTES) != hipSuccess || per_cu < 1) { fprintf(stderr, "kernel_launch: occupancy query says %d\n", per_cu); }
        (void)hipGetLastError();
        grid = cus;
    }
    if (grid < 0) return;
    unsigned char* ws = (unsigned char*)d_ws;
    (void)hipMemsetAsync(ws + WS_CTL, 0, CTL_ZERO_BYTES, stream);
    Args a{};
    for (int i = 0; i < 13; ++i) a.in[i] = (const float*)d_in[i];
    a.out = (float*)d_out; a.ws = ws;
    a.ph_lo = 0; a.ph_hi = 7; a.li = 0;
    hipLaunchKernelGGL(skel_fwd, dim3(grid), dim3(NWAVES * 64), LDS_BYTES, stream, a);
}
```

```cpp
#include <hip/hip_runtime.h>
#include <cstdio>
#include <cstdint>

typedef unsigned short bf16_t;
constexpr int NB = 2, SEQ = 8192, DM = 1024, M = NB * SEQ;
constexpr int NIN = 3088, DFF = 2816, NUP = 2 * DFF, NINP = 3328;
constexpr float EPS = 1e-6f;
constexpr float C2 = 0.18033688011112042f;

__device__ __forceinline__ unsigned f2bf(float f) { unsigned u = __builtin_bit_cast(unsigned, f); return (u + 0x7fffu + ((u >> 16) & 1u)) >> 16; }
__device__ __forceinline__ float bf2f(bf16_t h) { return __builtin_bit_cast(float, (unsigned)h << 16); }

__device__ const double INV_FREQ[32] = {1.0, 0.7498942093324559, 0.5623413251903491, 0.4216965034285822, 0.31622776601683794, 0.23713737056616552, 0.1778279410038923, 0.1333521432163324, 0.1, 0.07498942093324558, 0.05623413251903491, 0.042169650342858224, 0.03162277660168379, 0.023713737056616554, 0.01778279410038923, 0.01333521432163324, 0.01, 0.007498942093324558, 0.005623413251903491, 0.004216965034285823, 0.0031622776601683794, 0.0023713737056616554, 0.0017782794100389228, 0.001333521432163324, 0.001, 0.0007498942093324559, 0.0005623413251903491, 0.00042169650342858224, 0.00031622776601683794, 0.00023713737056616554, 0.00017782794100389227, 0.0001333521432163324};

__device__ __forceinline__ float wave_sum(float v) {
#pragma unroll
    for (int o = 1; o < 64; o <<= 1) v += __shfl_xor(v, o);
    return v;
}

struct IF1 { bf16_t *q, *k, *v, *gq, *gk, *gv, *sr; float *loga, *adec, *kmean; const float2* rope; };
__device__ __forceinline__ void moba_pair(const IF1& a, bf16_t* ymix, int gw, int lane) {
    const int row = gw >> 3, h = gw & 7, b = row / SEQ, t = row % SEQ, own = t >> 8;
    const bf16_t* qp = a.q + (size_t)row * 512 + 64 * h;
    float gate = -INFINITY;
    if (lane < own) { const float* km = a.kmean + ((size_t)(b * 32 + lane) * 8 + h) * 64; float s = 0.f;
        for (int p = 0; p < 64; ++p) s += bf2f(qp[p]) * km[p]; gate = s; }
    int selb[4]; int nsel = 0;
#pragma unroll
    for (int it = 0; it < 3; ++it) {
        float mv = gate; int mi = lane;
#pragma unroll
        for (int o = 1; o < 64; o <<= 1) { const float ov = __shfl_xor(mv, o); const int oi = __shfl_xor(mi, o); if (ov > mv || (ov == mv && oi < mi)) { mv = ov; mi = oi; } }
        if (mv > -INFINITY) { selb[it] = mi; nsel = it + 1; if (lane == mi) gate = -INFINITY; } else selb[it] = -1;
    }
    selb[3] = own;
    float sc[4][4];
    float mx = -INFINITY;
#pragma unroll
    for (int c = 0; c < 4; ++c) {
        const int blk = (c < 3) ? selb[c] : own; const bool valid = (c == 3) || (c < nsel);
#pragma unroll
        for (int u = 0; u < 4; ++u) { float s = -INFINITY;
            if (valid) { const int key = blk * 256 + u * 64 + lane;
                if (c < 3 || key <= t) { const bf16_t* kp = a.k + (size_t)(b * SEQ + key) * 512 + 64 * h; float d = 0.f;
                    for (int p = 0; p < 64; ++p) d += bf2f(qp[p]) * bf2f(kp[p]); s = d; } }
            sc[c][u] = s; mx = fmaxf(mx, s); }
    }
#pragma unroll
    for (int o = 1; o < 64; o <<= 1) mx = fmaxf(mx, __shfl_xor(mx, o));
    float l = 0.f;
#pragma unroll
    for (int c = 0; c < 4; ++c)
#pragma unroll
        for (int u = 0; u < 4; ++u) { const float pv = (sc[c][u] == -INFINITY) ? 0.f : exp2f(sc[c][u] - mx); sc[c][u] = pv; l += pv; }
    l = wave_sum(l);
    float acc = 0.f;
#pragma unroll
    for (int c = 0; c < 4; ++c) {
        const int blk = (c < 3) ? selb[c] : own; const bool valid = (c == 3) || (c < nsel);
        if (valid) {
#pragma unroll
            for (int u = 0; u < 4; ++u) {
                for (int j = 0; j < 64; ++j) { const float pj = __shfl(sc[c][u], j); const int key = blk * 256 + u * 64 + j;
                    acc += pj * bf2f(a.v[(size_t)(b * SEQ + key) * 512 + 64 * h + lane]); } } }
    }
    ymix[(size_t)row * 1024 + 64 * h + lane] = (bf16_t)f2bf(acc / l);
}

__device__ __forceinline__ void gla_rec_bh(const IF1& a, float* oraw, int bh, int v) {
    const int b = bh >> 2, h = bh & 3;
    float S[64];
#pragma unroll
    for (int d = 0; d < 64; ++d) S[d] = 0.f;
    for (int t = 0; t < SEQ; ++t) {
        const size_t row = (size_t)b * SEQ + t;
        const float vv = bf2f(a.gv[row * 512 + 128 * h + v]);
        const float* ad = a.adec + row * 256 + 64 * h; const bf16_t* kp = a.gk + row * 256 + 64 * h; const bf16_t* qp = a.gq + row * 256 + 64 * h;
        float o = 0.f;
#pragma unroll
        for (int d0 = 0; d0 < 64; d0 += 8) {
#pragma unroll
            for (int d = d0; d < d0 + 8; ++d) { S[d] = ad[d] * S[d] + bf2f(kp[d]) * vv; o += bf2f(qp[d]) * S[d]; }
            asm volatile("" ::: "memory"); }
        oraw[row * 512 + 128 * h + v] = o;
    }
}

__device__ __forceinline__ void gla_norm_rh(const float* oraw, const float* g, const bf16_t* sr, bf16_t* ymix, int row, int h, int lane) {
    const float o0 = oraw[(size_t)row * 512 + 128 * h + lane], o1 = oraw[(size_t)row * 512 + 128 * h + 64 + lane];
    const float ms = wave_sum(o0 * o0 + o1 * o1) * (1.0f / 128.0f); const float rstd = 1.0f / sqrtf(ms + EPS);
    const float y0 = o0 * rstd * g[128 * h + lane] * bf2f(sr[(size_t)row * 512 + 128 * h + lane]);
    const float y1 = o1 * rstd * g[128 * h + 64 + lane] * bf2f(sr[(size_t)row * 512 + 128 * h + 64 + lane]);
    ymix[(size_t)row * 1024 + 512 + 128 * h + lane] = (bf16_t)f2bf(y0); ymix[(size_t)row * 1024 + 512 + 128 * h + 64 + lane] = (bf16_t)f2bf(y1);
}


namespace pg8 {
#define PG8_LAS __attribute__((address_space(3)))
typedef unsigned short bf16_t;
typedef short bf16x8 __attribute__((ext_vector_type(8)));
typedef float f32x4 __attribute__((ext_vector_type(4)));
typedef unsigned u32x4 __attribute__((ext_vector_type(4)));
constexpr int BM = 256, BK = 64, HALF = 128, HTB = HALF * BK * 2  , STAGE_BYTES = 8 * HTB, NXCD = 8, WGM = 8;

__host__ __device__ __forceinline__ int lds_byte(int r, int c) { const int st = (r >> 4) * 2 + (c >> 5), rr = r & 15, cc = c & 31, ob = rr * 64 + cc * 2; return st * 1024 + (ob ^ (((ob >> 9) & 1) << 5)); }
__host__ __device__ __forceinline__ void stage_rc(int b, int& R, int& C) { const int st = b / 1024, sb = b % 1024, swz = sb ^ (((sb >> 9) & 1) << 5); R = (st >> 1) * 16 + swz / 64; C = (st & 1) * 32 + (swz % 64) / 2; }
__host__ __device__ __forceinline__ int perm32(int rho) { const int n = rho >> 4, i = rho & 15; return 8 * (i >> 2) + 4 * n + (i & 3); }

struct Unit { int pm, pn; };
struct Gemm { const bf16_t* A; const bf16_t* Bt; int M, N, K; };

struct StaticOrder {
    int nM, nN, nwg, G, c;
    __host__ __device__ void init(int nM_, int nN_, int G_, int c_) { nM = nM_; nN = nN_; nwg = nM * nN; G = G_; c = c_; }
    __host__ __device__ bool next(int i, Unit& u) const {
        const long L = (long)i * G + c; if (L >= nwg) return false;
        int wgid = (int)L; { const int q = nwg / NXCD, r = nwg % NXCD, xcd = wgid % NXCD, off = wgid / NXCD; wgid = (xcd < r ? xcd * (q + 1) : r * (q + 1) + (xcd - r) * q) + off; }
        const int nig = WGM * nN, gid = wgid / nig, fm = gid * WGM, gsz = (nM - fm) < WGM ? (nM - fm) : WGM;
        u.pm = fm + ((wgid % nig) % gsz); u.pn = (wgid % nig) / gsz; return true;
    }
    __device__ __forceinline__ void a_ready(const Unit&) const {}
    __device__ __forceinline__ void done(const Unit&) const {}
};

struct AMapStd { static constexpr int HALF_ROWS = 128; static __device__ __forceinline__ int rowmap(int R) { return R; } static __device__ __forceinline__ int tile_row(int pm) { return pm * 256; } };
struct AMapConv { static constexpr int HALF_ROWS = 64; static __device__ __forceinline__ int rowmap(int R) { return 126 * (R >> 6) + (R & 63); }
    static __device__ __forceinline__ int tile_row(int pm) { return (pm / 33) * SEQ + 252 * (pm % 33) - 2; } };

__device__ __forceinline__ unsigned cvt_pk_bf16(float lo, float hi) { unsigned r; asm volatile("v_cvt_pk_bf16_f32 %0, %1, %2" : "=v"(r) : "v"(lo), "v"(hi)); return r; }
__device__ __forceinline__ u32x4 pack8(const f32x4 a, const f32x4 b) { u32x4 w; w.x = cvt_pk_bf16(a[0], a[1]); w.y = cvt_pk_bf16(a[2], a[3]); w.z = cvt_pk_bf16(b[0], b[1]); w.w = cvt_pk_bf16(b[2], b[3]); return w; }
__device__ __forceinline__ float silu_f(float r) { return r * __builtin_amdgcn_rcpf(1.0f + __expf(-r)); }

struct EpiInProj {
    static constexpr bool PERM = true, AFTER_DRAIN = false;
    bf16_t *q, *k, *v, *gq, *gk, *gv, *sr; float *loga, *kmean; const float* rope; const float* b_gate;
    template <bool ISQ> __device__ __forceinline__ void rope_tile(const f32x4 (&acc)[2][2][4][2], const Unit& u, int row0, int cw, int fr) const {
        bf16_t* dst = ISQ ? q : k; const int colt = (u.pn & 1) * 256; const float sc = ISQ ? C2 : 1.0f;
        float ks[2][8];
#pragma unroll
        for (int bj = 0; bj < 2; ++bj)
#pragma unroll
            for (int e = 0; e < 8; ++e) ks[bj][e] = 0.f;
#pragma unroll
        for (int ai = 0; ai < 2; ++ai)
#pragma unroll
            for (int m = 0; m < 4; ++m) { const int row = row0 + ai * HALF + m * 16; const int t = row & (SEQ - 1);
#pragma unroll
                for (int bj = 0; bj < 2; ++bj) { const int col = colt + bj * HALF + cw; const int i0 = (col & 63) >> 1;
                    const float* rp = rope + (size_t)(t * 32 + i0) * 2; const f32x4 c0 = *(const f32x4*)rp, c1 = *(const f32x4*)(rp + 4);
                    const f32x4 a = acc[ai][bj][m][0], b = acc[ai][bj][m][1]; float o[8];
                    o[0] = a[0] * c0[0] - a[1] * c0[1]; o[1] = a[1] * c0[0] + a[0] * c0[1];
                    o[2] = a[2] * c0[2] - a[3] * c0[3]; o[3] = a[3] * c0[2] + a[2] * c0[3];
                    o[4] = b[0] * c1[0] - b[1] * c1[1]; o[5] = b[1] * c1[0] + b[0] * c1[1];
                    o[6] = b[2] * c1[2] - b[3] * c1[3]; o[7] = b[3] * c1[2] + b[2] * c1[3];
                    if (!ISQ) {
#pragma unroll
                        for (int e = 0; e < 8; ++e) ks[bj][e] += o[e]; }
                    u32x4 w; w.x = cvt_pk_bf16(o[0] * sc, o[1] * sc); w.y = cvt_pk_bf16(o[2] * sc, o[3] * sc); w.z = cvt_pk_bf16(o[4] * sc, o[5] * sc); w.w = cvt_pk_bf16(o[6] * sc, o[7] * sc);
                    *(u32x4*)(dst + (size_t)row * 512 + col) = w; }
                if (!ISQ) {
#pragma unroll
                    for (int bj = 0; bj < 2; ++bj)
#pragma unroll
                        for (int e = 0; e < 8; ++e) asm volatile("" : "+v"(ks[bj][e])); }
                asm volatile("" ::: "memory"); __builtin_amdgcn_sched_barrier(0); }
        if (!ISQ) {
#pragma unroll
            for (int bj = 0; bj < 2; ++bj)
#pragma unroll
                for (int e = 0; e < 8; ++e) { float s = ks[bj][e]; s += __shfl_xor(s, 1); s += __shfl_xor(s, 2); s += __shfl_xor(s, 4); s += __shfl_xor(s, 8);
                    if (fr == 0) __hip_atomic_fetch_add(kmean + (size_t)u.pm * 512 + colt + bj * HALF + cw + e, s * (1.0f / 256.0f), __ATOMIC_RELAXED, __HIP_MEMORY_SCOPE_AGENT); }
        }
    }
    __device__ __forceinline__ void operator()(const f32x4 (&acc)[2][2][4][2], const Unit& u, int wr, int wc, int fr, int fq) const {
        const int pn = u.pn; const int row0 = u.pm * BM + wr * 64 + fr; const int cw = wc * 32 + 8 * fq;
        if (pn < 2) { rope_tile<true>(acc, u, row0, cw, fr); return; }
        if (pn < 4) { rope_tile<false>(acc, u, row0, cw, fr); return; }
        if (pn == 12) {
            f32x4 bv[2][2];
#pragma unroll
            for (int bj = 0; bj < 2; ++bj)
#pragma unroll
                for (int n = 0; n < 2; ++n) bv[bj][n] = *(const f32x4*)(b_gate + bj * HALF + cw + 4 * n);
#pragma unroll
            for (int ai = 0; ai < 2; ++ai)
#pragma unroll
                for (int m = 0; m < 4; ++m) { const int row = row0 + ai * HALF + m * 16;
#pragma unroll
                    for (int bj = 0; bj < 2; ++bj)
#pragma unroll
                        for (int n = 0; n < 2; ++n) { const f32x4 z = acc[ai][bj][m][n] + bv[bj][n]; f32x4 la;
#pragma unroll
                            for (int e = 0; e < 4; ++e) la[e] = (fminf(z[e], 0.f) - __logf(1.0f + __expf(-fabsf(z[e])))) * (1.0f / 16.0f);
                            *(f32x4*)(loga + (size_t)row * 256 + bj * HALF + cw + 4 * n) = la; } }
            return;
        }
        bf16_t* dst; int ld, colt, mode;
        if (pn < 6) { dst = v; ld = 512; colt = (pn - 4) * 256; mode = 0; }
        else if (pn == 6) { dst = gq; ld = 256; colt = 0; mode = 1; }
        else if (pn == 7) { dst = gk; ld = 256; colt = 0; mode = 0; }
        else if (pn < 10) { dst = gv; ld = 512; colt = (pn - 8) * 256; mode = 0; }
        else { dst = sr; ld = 512; colt = (pn - 10) * 256; mode = 2; }
        const float sc = (mode == 1) ? 0.125f : 1.0f;
#pragma unroll
        for (int ai = 0; ai < 2; ++ai)
#pragma unroll
            for (int m = 0; m < 4; ++m) { bf16_t* rowp = dst + (size_t)(row0 + ai * HALF + m * 16) * ld + colt + cw;
#pragma unroll
                for (int bj = 0; bj < 2; ++bj) { f32x4 a = acc[ai][bj][m][0], b = acc[ai][bj][m][1];
                    if (mode == 2) {
#pragma unroll
                        for (int e = 0; e < 4; ++e) { a[e] = silu_f(a[e]); b[e] = silu_f(b[e]); } }
                    else { a = a * sc; b = b * sc; }
                    *(u32x4*)(rowp + bj * HALF) = pack8(a, b); } }
    }
};

struct EpiOutProj {
    static constexpr bool PERM = true, AFTER_DRAIN = false;
    const float* x; float* h; bf16_t* hs; const float* g; float* ssq;
    __device__ __forceinline__ void operator()(const f32x4 (&acc)[2][2][4][2], const Unit& u, int wr, int wc, int fr, int fq) const {
        const int row0 = u.pm * BM + wr * 64 + fr; const int col0 = u.pn * BM + wc * 32 + 8 * fq;
        f32x4 gv[2][2];
#pragma unroll
        for (int bj = 0; bj < 2; ++bj)
#pragma unroll
            for (int n = 0; n < 2; ++n) gv[bj][n] = *(const f32x4*)(g + col0 + bj * HALF + 4 * n);
#pragma unroll
        for (int ai = 0; ai < 2; ++ai)
#pragma unroll
            for (int m = 0; m < 4; ++m) { const int row = row0 + ai * HALF + m * 16; const size_t off = (size_t)row * DM + col0; float ss = 0.f;
#pragma unroll
                for (int bj = 0; bj < 2; ++bj) { const f32x4 xa = *(const f32x4*)(x + off + bj * HALF), xb = *(const f32x4*)(x + off + bj * HALF + 4);
                    const f32x4 ha = xa + acc[ai][bj][m][0], hb = xb + acc[ai][bj][m][1];
                    *(f32x4*)(h + off + bj * HALF) = ha; *(f32x4*)(h + off + bj * HALF + 4) = hb;
                    ss += (ha[0] * ha[0] + ha[1] * ha[1]) + (ha[2] * ha[2] + ha[3] * ha[3]) + (hb[0] * hb[0] + hb[1] * hb[1]) + (hb[2] * hb[2] + hb[3] * hb[3]);
                    *(u32x4*)(hs + off + bj * HALF) = pack8(ha * gv[bj][0], hb * gv[bj][1]); }
                ss += __shfl_xor(ss, 16); ss += __shfl_xor(ss, 32);
                if (fq == 0) ssq[(size_t)row * 16 + u.pn * 4 + wc] = ss; }
    }
};
struct EpiDown {
    static constexpr bool PERM = true, AFTER_DRAIN = false;
    float* y; float* ssq;
    __device__ __forceinline__ void operator()(const f32x4 (&acc)[2][2][4][2], const Unit& u, int wr, int wc, int fr, int fq) const {
        const int row0 = u.pm * BM + wr * 64 + fr; const int col0 = u.pn * BM + wc * 32 + 8 * fq;
#pragma unroll
        for (int ai = 0; ai < 2; ++ai)
#pragma unroll
            for (int m = 0; m < 4; ++m) { const int row = row0 + ai * HALF + m * 16; const size_t off = (size_t)row * DM + col0; float ss = 0.f;
#pragma unroll
                for (int bj = 0; bj < 2; ++bj) { const f32x4 xa = *(const f32x4*)(y + off + bj * HALF), xb = *(const f32x4*)(y + off + bj * HALF + 4);
                    const f32x4 ha = xa + acc[ai][bj][m][0], hb = xb + acc[ai][bj][m][1];
                    *(f32x4*)(y + off + bj * HALF) = ha; *(f32x4*)(y + off + bj * HALF + 4) = hb;
                    ss += (ha[0] * ha[0] + ha[1] * ha[1]) + (ha[2] * ha[2] + ha[3] * ha[3]) + (hb[0] * hb[0] + hb[1] * hb[1]) + (hb[2] * hb[2] + hb[3] * hb[3]); }
                ss += __shfl_xor(ss, 16); ss += __shfl_xor(ss, 32);
                if (fq == 0) ssq[(size_t)row * 16 + u.pn * 4 + wc] = ss; }
    }
};
struct EpiUp {
    static constexpr bool PERM = true, AFTER_DRAIN = false;
    const float* ssq; const float* cw; const float* cb; bf16_t* act;
    __device__ __forceinline__ void operator()(const f32x4 (&acc)[2][2][4][2], const Unit& u, int wr, int wc, int fr, int fq) const {
        const int b = u.pm / 33, j = u.pm % 33; const int tb = 252 * j - 2 + 126 * wr;
        const int ch0 = u.pn * 128 + wc * 32 + 8 * fq;
        float rs[8];
#pragma unroll
        for (int g8 = 0; g8 < 8; ++g8) { int row = b * SEQ + tb + 16 * g8 + fr; row = row < 0 ? 0 : (row > M - 1 ? M - 1 : row);
            const f32x4* sp = (const f32x4*)(ssq + (size_t)row * 16); const f32x4 s0 = sp[0], s1 = sp[1], s2 = sp[2], s3 = sp[3];
            const float s = ((s0[0] + s0[1]) + (s0[2] + s0[3])) + ((s1[0] + s1[1]) + (s1[2] + s1[3])) + ((s2[0] + s2[1]) + (s2[2] + s2[3])) + ((s3[0] + s3[1]) + (s3[2] + s3[3]));
            rs[g8] = __builtin_amdgcn_rsqf(s * (1.0f / DM) + EPS);
            asm volatile("" : "+v"(rs[g8]) :: "memory"); __builtin_amdgcn_sched_barrier(0); }
        const int lane = fq * 16 + fr; const int src1 = ((lane & 48) | ((fr + 15) & 15)) * 4, src2 = ((lane & 48) | ((fr + 14) & 15)) * 4;
        const bool last1 = (fr == 15), last2 = (fr >= 14);
#pragma unroll
        for (int n = 0; n < 2; ++n) {
            const int ch = ch0 + 4 * n;
            const f32x4 wg0 = *(const f32x4*)(cw + ch), wg1 = *(const f32x4*)(cw + NUP + ch), wg2 = *(const f32x4*)(cw + 2 * NUP + ch), bg = *(const f32x4*)(cb + ch);
            const f32x4 wv0 = *(const f32x4*)(cw + DFF + ch), wv1 = *(const f32x4*)(cw + NUP + DFF + ch), wv2 = *(const f32x4*)(cw + 2 * NUP + DFF + ch), bvv = *(const f32x4*)(cb + DFF + ch);
            f32x4 pg = {0.f, 0.f, 0.f, 0.f}, pv = {0.f, 0.f, 0.f, 0.f};
#pragma unroll
            for (int g8 = 0; g8 < 8; ++g8) { const int ai = g8 >> 2, m = g8 & 3; const int qi = 16 * g8 + fr; const int t = tb + qi; const bool t1ok = t >= 1, t2ok = t >= 2;
                const f32x4 cg = acc[ai][0][m][n] * rs[g8], cv = acc[ai][1][m][n] * rs[g8]; f32x4 o;
#pragma unroll
                for (int e = 0; e < 4; ++e) {
                    float g1 = __builtin_bit_cast(float, __builtin_amdgcn_ds_bpermute(src1, __builtin_bit_cast(int, last1 ? pg[e] : cg[e])));
                    float g2 = __builtin_bit_cast(float, __builtin_amdgcn_ds_bpermute(src2, __builtin_bit_cast(int, last2 ? pg[e] : cg[e])));
                    g1 = t1ok ? g1 : 0.f; g2 = t2ok ? g2 : 0.f;
                    const float gate = silu_f(bg[e] + wg2[e] * cg[e] + wg1[e] * g1 + wg0[e] * g2);
                    float v1 = __builtin_bit_cast(float, __builtin_amdgcn_ds_bpermute(src1, __builtin_bit_cast(int, last1 ? pv[e] : cv[e])));
                    float v2 = __builtin_bit_cast(float, __builtin_amdgcn_ds_bpermute(src2, __builtin_bit_cast(int, last2 ? pv[e] : cv[e])));
                    v1 = t1ok ? v1 : 0.f; v2 = t2ok ? v2 : 0.f;
                    o[e] = gate * (bvv[e] + wv2[e] * cv[e] + wv1[e] * v1 + wv0[e] * v2); }
                if (qi >= 2 && t < SEQ) { typedef unsigned u32x2v __attribute__((ext_vector_type(2))); u32x2v w; w.x = cvt_pk_bf16(o[0], o[1]); w.y = cvt_pk_bf16(o[2], o[3]);
                    *(u32x2v*)(act + (size_t)(b * SEQ + t) * DFF + ch) = w; }
                pg = cg; pv = cv; __builtin_amdgcn_sched_barrier(0); }
        }
    }
};
template <class Epi, class Sched, class AMap, bool ALIGN_EPI = false, bool SP2 = false>
__device__ __forceinline__ void gemm_phase(PG8_LAS unsigned char* lds, const Gemm g, const Sched& S, const Epi& E) {
    const int tid = threadIdx.x, wid = __builtin_amdgcn_readfirstlane(tid >> 6), lane = tid & 63, wr = wid >> 2, wc = wid & 3, fr = lane & 15, fq = lane >> 4;
    const int K = g.K, nt = K / BK;
    unsigned voffA[2], voffB[2];
#pragma unroll
    for (int i = 0; i < 2; ++i) { int R, C; stage_rc(tid * 16 + i * 8192, R, C); const int Rb = Epi::PERM ? ((R & ~31) + perm32(R & 31)) : R;
        voffA[i] = (unsigned)(AMap::rowmap(R) * K + C) * 2u; voffB[i] = (unsigned)(Rb * K + C) * 2u; }
    const size_t kstep = (size_t)(BK * 2);
    const size_t hstepA = (size_t)AMap::HALF_ROWS * K * 2, hstepB = (size_t)HALF * K * 2;
    const size_t tstepB = 2 * hstepB;
    const unsigned ldsw = (unsigned)wid * 1024u;
    const int aoff = lds_byte(wr * 64 + fr, fq * 8), boff = lds_byte(wc * 32 + fr, fq * 8);
#define PG8_SA(b, h) (((b) * 2 + (h)) * HTB)
#define PG8_SB(b, h) ((4 + (b) * 2 + (h)) * HTB)
#define PG8_STAGE(bufoff, gbase, voff) do { _Pragma("unroll") for (int _i = 0; _i < 2; ++_i) \
        __builtin_amdgcn_global_load_lds((const unsigned*)((const char*)(gbase) + (voff)[_i]), (PG8_LAS unsigned*)(lds + (bufoff) + ldsw + _i * 8192), 16, 0, 0); } while (0)
#define PG8_LDA(dst, b, h) do { _Pragma("unroll") for (int m = 0; m < 4; ++m) _Pragma("unroll") for (int k = 0; k < 2; ++k) dst[m][k] = *(const PG8_LAS bf16x8*)(lds + PG8_SA(b, h) + aoff + m * 2048 + k * 1024); } while (0)
#define PG8_LDB(dst, b, h) do { _Pragma("unroll") for (int n = 0; n < 2; ++n) _Pragma("unroll") for (int k = 0; k < 2; ++k) dst[n][k] = *(const PG8_LAS bf16x8*)(lds + PG8_SB(b, h) + boff + n * 2048 + k * 1024); } while (0)
#define PG8_MMA(ai, bj, At, Bt) do { __builtin_amdgcn_s_setprio(1); _Pragma("unroll") for (int m = 0; m < 4; ++m) _Pragma("unroll") for (int n = 0; n < 2; ++n) _Pragma("unroll") for (int k = 0; k < 2; ++k) \
        acc[ai][bj][m][n] = __builtin_amdgcn_mfma_f32_16x16x32_bf16(Bt[n][k], At[m][k], acc[ai][bj][m][n], 0, 0, 0); __builtin_amdgcn_s_setprio(0); } while (0)
#define PG8_WAIT_V(n) asm volatile("s_waitcnt vmcnt(" #n ")" ::: "memory")
#define PG8_WAIT_L(n) asm volatile("s_waitcnt lgkmcnt(" #n ")" ::: "memory")
#define PG8_BAR __builtin_amdgcn_s_barrier()
#define PG8_SCHED __builtin_amdgcn_sched_barrier(0)
    Unit cur, nxt; int ui = 0;
    if (!S.next(0, cur)) return;
    f32x4 acc[2][2][4][2];
#pragma unroll
    for (int a = 0; a < 2; ++a)
#pragma unroll
        for (int b = 0; b < 2; ++b)
#pragma unroll
            for (int m = 0; m < 4; ++m)
#pragma unroll
                for (int n = 0; n < 2; ++n) acc[a][b][m][n] = (f32x4){0.f, 0.f, 0.f, 0.f};
    bf16x8 At[4][2], B0[2][2], B1[2][2];
    const char* cA = (const char*)g.A + (long)AMap::tile_row(cur.pm) * K * 2; const char* cB = (const char*)g.Bt + (size_t)cur.pn * tstepB;
    S.a_ready(cur);
    if constexpr (SP2) {
        PG8_STAGE(PG8_SB(0, 0), cB, voffB); PG8_STAGE(PG8_SB(0, 1), cB + hstepB, voffB); PG8_STAGE(PG8_SA(0, 0), cA, voffA); PG8_STAGE(PG8_SA(0, 1), cA + hstepA, voffA);
        if (wr == 1) PG8_BAR;
        PG8_WAIT_V(2); PG8_BAR;
        PG8_STAGE(PG8_SB(1, 0), cB + kstep, voffB); PG8_STAGE(PG8_SA(1, 0), cA + kstep, voffA); PG8_STAGE(PG8_SB(1, 1), cB + hstepB + kstep, voffB);
        PG8_WAIT_V(6); PG8_BAR;
    } else {
        PG8_STAGE(PG8_SB(0, 0), cB, voffB); PG8_STAGE(PG8_SA(0, 0), cA, voffA); PG8_STAGE(PG8_SB(0, 1), cB + hstepB, voffB); PG8_STAGE(PG8_SA(0, 1), cA + hstepA, voffA);
        if (wr == 1) PG8_BAR;
        PG8_WAIT_V(4); PG8_BAR;
        PG8_STAGE(PG8_SB(1, 0), cB + kstep, voffB); PG8_STAGE(PG8_SA(1, 0), cA + kstep, voffA); PG8_STAGE(PG8_SB(1, 1), cB + hstepB + kstep, voffB);
        PG8_WAIT_V(6); PG8_BAR;
    }
    for (;;) {
        const bool has_next = S.next(ui + 1, nxt);
        const char* nA = has_next ? (const char*)g.A + (long)AMap::tile_row(nxt.pm) * K * 2 : cA; const char* nB = has_next ? (const char*)g.Bt + (size_t)nxt.pn * tstepB : cB;
        for (int t = 0; t < nt; t += 2) {
            const bool last = (t == nt - 2);
            const char* a1 = cA + (size_t)(t + 1) * kstep;
            const char* a2 = last ? nA : cA + (size_t)(t + 2) * kstep; const char* b2 = last ? nB : cB + (size_t)(t + 2) * kstep;
            const char* a3 = a2 + kstep; const char* b3 = b2 + kstep;
            if (last && has_next) S.a_ready(nxt);
            if constexpr (SP2) {
            PG8_LDB(B0, 0, 0); PG8_LDB(B1, 0, 1); PG8_SCHED; PG8_LDA(At, 0, 0); PG8_STAGE(PG8_SA(1, 1), a1 + hstepA, voffA);
            PG8_WAIT_V(8); PG8_WAIT_L(0); PG8_BAR; PG8_MMA(0, 0, At, B0); PG8_MMA(0, 1, At, B1); PG8_BAR; PG8_SCHED;
            PG8_LDA(At, 0, 1); PG8_STAGE(PG8_SB(0, 0), b2, voffB); PG8_STAGE(PG8_SB(0, 1), b2 + hstepB, voffB); PG8_STAGE(PG8_SA(0, 0), a2, voffA);
            PG8_WAIT_V(8); PG8_WAIT_L(0); PG8_BAR; PG8_MMA(1, 0, At, B0); PG8_MMA(1, 1, At, B1); PG8_BAR; PG8_SCHED;
            PG8_LDB(B0, 1, 0); PG8_LDB(B1, 1, 1); PG8_SCHED; PG8_LDA(At, 1, 0); PG8_STAGE(PG8_SA(0, 1), a2 + hstepA, voffA);
            PG8_WAIT_V(8); PG8_WAIT_L(0); PG8_BAR; PG8_MMA(0, 0, At, B0); PG8_MMA(0, 1, At, B1); PG8_BAR; PG8_SCHED;
            PG8_LDA(At, 1, 1); PG8_STAGE(PG8_SB(1, 0), b3, voffB); PG8_STAGE(PG8_SB(1, 1), b3 + hstepB, voffB); PG8_STAGE(PG8_SA(1, 0), a3, voffA);
            PG8_WAIT_V(8); PG8_WAIT_L(0); PG8_BAR; PG8_MMA(1, 0, At, B0); PG8_MMA(1, 1, At, B1); PG8_BAR; PG8_SCHED;
            } else {
            PG8_LDB(B0, 0, 0); PG8_SCHED; PG8_LDA(At, 0, 0); PG8_STAGE(PG8_SA(1, 1), a1 + hstepA, voffA);
            PG8_WAIT_L(8); PG8_BAR; PG8_WAIT_L(0); PG8_MMA(0, 0, At, B0); PG8_BAR; PG8_SCHED;
            PG8_LDB(B1, 0, 1); PG8_STAGE(PG8_SB(0, 0), b2, voffB);
            PG8_BAR; PG8_WAIT_L(0); PG8_MMA(0, 1, At, B1); PG8_BAR;
            PG8_LDA(At, 0, 1); PG8_STAGE(PG8_SA(0, 0), a2, voffA);
            PG8_BAR; PG8_WAIT_L(0); PG8_MMA(1, 0, At, B0); PG8_BAR; PG8_SCHED;
            PG8_STAGE(PG8_SB(0, 1), b2 + hstepB, voffB);
            PG8_WAIT_V(6); PG8_BAR; PG8_MMA(1, 1, At, B1); PG8_BAR;
            PG8_LDB(B0, 1, 0); PG8_SCHED; PG8_LDA(At, 1, 0); PG8_STAGE(PG8_SA(0, 1), a2 + hstepA, voffA);
            PG8_WAIT_L(8); PG8_BAR; PG8_WAIT_L(0); PG8_MMA(0, 0, At, B0); PG8_BAR; PG8_SCHED;
            PG8_LDB(B1, 1, 1); PG8_STAGE(PG8_SB(1, 0), b3, voffB);
            PG8_BAR; PG8_WAIT_L(0); PG8_MMA(0, 1, At, B1); PG8_BAR;
            PG8_LDA(At, 1, 1); PG8_STAGE(PG8_SA(1, 0), a3, voffA);
            PG8_BAR; PG8_WAIT_L(0); PG8_MMA(1, 0, At, B0); PG8_BAR; PG8_SCHED;
            PG8_STAGE(PG8_SB(1, 1), b3 + hstepB, voffB);
            PG8_WAIT_V(6); PG8_BAR; PG8_MMA(1, 1, At, B1); PG8_BAR;
            }
        }
        if constexpr (ALIGN_EPI) { if (wr == 0) PG8_BAR; }
        if constexpr (!Epi::AFTER_DRAIN) { E(acc, cur, wr, wc, fr, fq); S.done(cur); }
        if (!has_next) break;
#pragma unroll
        for (int a = 0; a < 2; ++a)
#pragma unroll
            for (int b = 0; b < 2; ++b)
#pragma unroll
                for (int m = 0; m < 4; ++m)
#pragma unroll
                    for (int n = 0; n < 2; ++n) acc[a][b][m][n] = (f32x4){0.f, 0.f, 0.f, 0.f};
        cur = nxt; cA = nA; cB = nB; ++ui;
        if constexpr (ALIGN_EPI) { if (wr == 1) PG8_BAR; }
    }
    PG8_WAIT_V(0);
    if constexpr (!ALIGN_EPI) { if (wr == 0) PG8_BAR; }
    PG8_BAR;
    if constexpr (Epi::AFTER_DRAIN) { E.fused(acc, cur, wr, wc, fr, fq, lds, wid, lane); S.done(cur); }
#undef PG8_SA
#undef PG8_SB
#undef PG8_STAGE
#undef PG8_LDA
#undef PG8_LDB
#undef PG8_MMA
#undef PG8_WAIT_V
#undef PG8_WAIT_L
#undef PG8_BAR
#undef PG8_SCHED
}
}

#include <hip/hip_bf16.h>
#include <cmath>
namespace attn_body {
using bf16=__hip_bfloat16;
using bf16x8=__attribute__((ext_vector_type(8)))short;
using s16x4=__attribute__((ext_vector_type(4)))short;
using f32x16=__attribute__((ext_vector_type(16)))float;
using u32x4=__attribute__((ext_vector_type(4)))unsigned;
using f32x4_t=__attribute__((ext_vector_type(4)))float;
constexpr int BATCH=2,NHEAD=8,SEQ=8192,D=64,DM=NHEAD*D,OPITCH=1024;
constexpr int NW=8,QBLK=32,QB=QBLK*NW,KVBLK=64,NQB=SEQ/QB;
constexpr int ATTN_PITCH=DM, ATTN_UNIT_ROWS=QB;
__device__ __forceinline__ int crow(int r,int hi){return (r&3)+8*(r>>2)+4*hi;}
#define SBAR() __builtin_amdgcn_sched_barrier(0)
__device__ __forceinline__ void cmask(f32x16&p0,f32x16&p1,int jb,int qrel,int hi){
  const float NEG=-INFINITY; int kb=64*jb+4*hi;
  #pragma unroll
  for(int r=0;r<16;++r){int kv=kb+(r&3)+8*(r>>2); if(kv>qrel)p0[r]=NEG; if(kv+32>qrel)p1[r]=NEG;}
}

constexpr int NSLOT=3, SLOTB=8192;
constexpr int LDS_K=0, LDS_V=NSLOT*SLOTB, LDS_WS=2*NSLOT*SLOTB, LDS_OST=LDS_WS+NW*64*4, LDS_BYTES=LDS_OST+NW*4096;
constexpr float C2=0.125f*1.4426950408889634f;
__device__ __forceinline__ void glds16(const void*gsrc,unsigned lds_dst){unsigned keep;
  asm volatile("s_mov_b32 %0, m0\n\ts_mov_b32 m0, %2\n\ts_nop 0\n\tglobal_load_lds_dwordx4 %1, off\n\ts_mov_b32 m0, %0":"=&s"(keep):"v"(gsrc),"s"(lds_dst):"memory");}
__device__ __forceinline__ float max3f(float a,float b,float c){float r;asm("v_max3_f32 %0, %1, %2, %3":"=v"(r):"v"(a),"v"(b),"v"(c));return r;}
__device__ __forceinline__ float max2f(float a,float b){float r;asm("v_max_f32_e32 %0, %1, %2":"=v"(r):"v"(a),"v"(b));return r;}
__device__ __forceinline__ float fadd_s(float a,float b){float r;asm("v_add_f32_e32 %0, %1, %2":"=v"(r):"v"(a),"v"(b));return r;}
__device__ __forceinline__ float fsub_s(float a,float b){float r;asm("v_sub_f32_e32 %0, %1, %2":"=v"(r):"v"(a),"v"(b));return r;}
typedef float f32x2_t __attribute__((ext_vector_type(2))); typedef __bf16 bf16x2_t __attribute__((ext_vector_type(2)));
__device__ __forceinline__ unsigned cvtpk_s(float lo,float hi){f32x2_t v={lo,hi};bf16x2_t b=__builtin_convertvector(v,bf16x2_t);return __builtin_bit_cast(unsigned,b);}
#define WAIT_BAR(N) asm volatile("s_waitcnt vmcnt(" #N ") lgkmcnt(0)\n\ts_barrier":::"memory")

__device__ __forceinline__ void qkt(f32x16&p0,f32x16&p1,const char*Kslot,const bf16x8*qr,const f32x16&negm,int r32,int hi){
  const char*kb=Kslot+hi*1024+r32*16;
  #pragma unroll
  for(int d0=0;d0<4;++d0){
    const bf16x8 b0=*reinterpret_cast<const bf16x8*>(kb+d0*2048);
    const bf16x8 b1=*reinterpret_cast<const bf16x8*>(kb+d0*2048+512);
    if(d0==0){p0=__builtin_amdgcn_mfma_f32_32x32x16_bf16(b0,qr[0],negm,0,0,0);p1=__builtin_amdgcn_mfma_f32_32x32x16_bf16(b1,qr[0],negm,0,0,0);}
    else{p0=__builtin_amdgcn_mfma_f32_32x32x16_bf16(b0,qr[d0],p0,0,0,0);p1=__builtin_amdgcn_mfma_f32_32x32x16_bf16(b1,qr[d0],p1,0,0,0);}}
}
typedef __attribute__((address_space(3))) const char* lds_cptr;
typedef short v4i16_t __attribute__((ext_vector_type(4)));
__device__ __forceinline__ void kload8(bf16x8*kf,lds_cptr kp){
  kf[0]=*(const __attribute__((address_space(3))) bf16x8*)(kp);      kf[1]=*(const __attribute__((address_space(3))) bf16x8*)(kp+512);
  kf[2]=*(const __attribute__((address_space(3))) bf16x8*)(kp+2048); kf[3]=*(const __attribute__((address_space(3))) bf16x8*)(kp+2560);
  kf[4]=*(const __attribute__((address_space(3))) bf16x8*)(kp+4096); kf[5]=*(const __attribute__((address_space(3))) bf16x8*)(kp+4608);
  kf[6]=*(const __attribute__((address_space(3))) bf16x8*)(kp+6144); kf[7]=*(const __attribute__((address_space(3))) bf16x8*)(kp+6656);
}
__device__ __forceinline__ void kload2(bf16x8*kf,lds_cptr kp,int j){ kf[2*j]=*(const __attribute__((address_space(3))) bf16x8*)(kp+j*2048); kf[2*j+1]=*(const __attribute__((address_space(3))) bf16x8*)(kp+j*2048+512); }
__device__ __forceinline__ s16x4 vtr(lds_cptr p){ return __builtin_bit_cast(s16x4,__builtin_amdgcn_ds_read_tr16_b64_v4i16((__attribute__((address_space(3))) v4i16_t*)p)); }
__device__ __forceinline__ float rowmax(const f32x16&p0,const f32x16&p1){
  float a=max3f(p0[0],p0[1],p1[0]),b=max3f(p0[2],p0[3],p1[1]);a=max3f(a,p1[2],p1[3]);
  #pragma unroll
  for(int r=4;r<16;r+=4){a=max3f(a,p0[r],p0[r+1]);b=max3f(b,p0[r+2],p0[r+3]);a=max3f(a,p1[r],p1[r+1]);b=max3f(b,p1[r+2],p1[r+3]);}
  const float m=max2f(a,b);
  auto rr=__builtin_amdgcn_permlane32_swap(__float_as_uint(m),__float_as_uint(m),false,false);
  return max2f(__uint_as_float(rr[0]),__uint_as_float(rr[1]));
}
__device__ __forceinline__ void pv(f32x16*o,int vb,bf16x8 pa0,bf16x8 pa1,bf16x8 pa2,bf16x8 pa3){
  #pragma unroll
  for(int d0=0;d0<2;++d0){s16x4 lo[4],hi[4];
    #pragma unroll
    for(int ks=0;ks<4;++ks){
      asm volatile("ds_read_b64_tr_b16 %0,%1 offset:%c2":"=&v"(lo[ks]):"v"(vb),"i"(d0*4096+ks*1024):"memory");
      asm volatile("ds_read_b64_tr_b16 %0,%1 offset:%c2":"=&v"(hi[ks]):"v"(vb),"i"(d0*4096+ks*1024+512):"memory");}
    asm volatile("s_waitcnt lgkmcnt(0)":::"memory");SBAR();
    #define PK(k) (bf16x8){lo[k][0],lo[k][1],lo[k][2],lo[k][3],hi[k][0],hi[k][1],hi[k][2],hi[k][3]}
    o[d0]=__builtin_amdgcn_mfma_f32_32x32x16_bf16(pa0,PK(0),o[d0],0,0,0);
    o[d0]=__builtin_amdgcn_mfma_f32_32x32x16_bf16(pa1,PK(1),o[d0],0,0,0);
    o[d0]=__builtin_amdgcn_mfma_f32_32x32x16_bf16(pa2,PK(2),o[d0],0,0,0);
    o[d0]=__builtin_amdgcn_mfma_f32_32x32x16_bf16(pa3,PK(3),o[d0],0,0,0);
    #undef PK
  }
}

#ifndef ATTN_STORE16
#define ATTN_STORE16(p,v) (*(u32x4*)(p)=(v))
#endif
template<int THRL> __device__ __forceinline__ void attn_unit(int b,int h,int qb,const bf16*Q,const bf16*__restrict__ K,const bf16*__restrict__ V,bf16*O,const float*__restrict__ kmean,char*shm){
  const int tid=threadIdx.x,lane=tid&63,r32=lane&31,hi=lane>>5; const int wid=__builtin_amdgcn_readfirstlane(tid>>6);
  const long rowbase=(long)b*SEQ; const int q0=qb*QB;
  const bf16*Qw=Q+(rowbase+q0+wid*QBLK)*DM+h*D;
  const bf16*Kh=K+rowbase*DM+h*D,*Vh=V+rowbase*DM+h*D;
  const unsigned lds0=(unsigned)(uintptr_t)shm;
  float*wsf=(float*)(shm+LDS_WS)+wid*64;
  const bf16*ksrc=Kh+(long)lane*DM+wid*8;
  const bf16*vsrc=Vh+(long)(16*(wid&3)+(lane>>2))*DM+(wid>>2)*32+(lane&3)*8;
  const unsigned kdst=lds0+LDS_K+wid*1024, vdst=lds0+LDS_V+wid*1024;
  #define DMA_K(t,slot) glds16(ksrc+(long)(t)*KVBLK*DM,(unsigned)__builtin_amdgcn_readfirstlane(kdst+(slot)))
  #define DMA_V(t,slot) glds16(vsrc+(long)(t)*KVBLK*DM,(unsigned)__builtin_amdgcn_readfirstlane(vdst+(slot)))
  const int vb0=(int)(lds0+LDS_V)+((lane>>4)&1)*32+(lane&3)*8+(4*hi+((lane&15)>>2))*64;
  const char*Kbase=shm+LDS_K; bf16x8 kf[8];
  const lds_cptr shm3=(lds_cptr)shm; const lds_cptr kp0=shm3+LDS_K+hi*1024+r32*16; const lds_cptr vp0=shm3+LDS_V+((lane>>4)&1)*32+(lane&3)*8+(4*hi+((lane&15)>>2))*64;
  const int NT=(q0+QB)/KVBLK;
  DMA_K(0,0);DMA_V(0,0);DMA_K(1,SLOTB);
  bf16x8 qr[4];
  #pragma unroll
  for(int d0=0;d0<4;++d0)qr[d0]=*reinterpret_cast<const bf16x8*>(&Qw[(long)r32*DM+d0*16+hi*8]);
  unsigned selmask=0u;
  if(qb>0){
    f32x16 g=f32x16{};
    const float*kmrow=kmean+((long)(b*32+r32)*NHEAD+h)*D+hi*8;
    #pragma unroll
    for(int d0=0;d0<4;++d0){
      const f32x4_t a=*reinterpret_cast<const f32x4_t*>(kmrow+d0*16),c=*reinterpret_cast<const f32x4_t*>(kmrow+d0*16+4);
      u32x4 hw,lw; float hf[8],x[8]={a[0],a[1],a[2],a[3],c[0],c[1],c[2],c[3]};
      hw[0]=cvtpk_s(x[0],x[1]);hw[1]=cvtpk_s(x[2],x[3]);hw[2]=cvtpk_s(x[4],x[5]);hw[3]=cvtpk_s(x[6],x[7]);
      #pragma unroll
      for(int j=0;j<8;++j)hf[j]=__uint_as_float((j&1)?(hw[j>>1]&0xffff0000u):(hw[j>>1]<<16));
      lw[0]=cvtpk_s(x[0]-hf[0],x[1]-hf[1]);lw[1]=cvtpk_s(x[2]-hf[2],x[3]-hf[3]);lw[2]=cvtpk_s(x[4]-hf[4],x[5]-hf[5]);lw[3]=cvtpk_s(x[6]-hf[6],x[7]-hf[7]);
      g=__builtin_amdgcn_mfma_f32_32x32x16_bf16(__builtin_bit_cast(bf16x8,hw),qr[d0],g,0,0,0);
      g=__builtin_amdgcn_mfma_f32_32x32x16_bf16(__builtin_bit_cast(bf16x8,lw),qr[d0],g,0,0,0);}
    float b1=-INFINITY,b2=-INFINITY,b3=-INFINITY;int i1=99,i2=99,i3=99;
    #define INS(x_,n_) do{const float xx_=(x_);const int nn_=(n_); const bool c1=(xx_>b1)||(xx_==b1&&nn_<i1),c2=(xx_>b2)||(xx_==b2&&nn_<i2),c3=(xx_>b3)||(xx_==b3&&nn_<i3); \
      b3=c2?b2:(c3?xx_:b3); i3=c2?i2:(c3?nn_:i3); b2=c1?b1:(c2?xx_:b2); i2=c1?i1:(c2?nn_:i2); b1=c1?xx_:b1; i1=c1?nn_:i1; }while(0)
    #pragma unroll
    for(int r=0;r<16;++r){const int n=crow(r,hi); const float x=(n<qb)?g[r]:-INFINITY; INS(x,n);}
    { const float p1=__shfl_xor(b1,32),p2=__shfl_xor(b2,32),p3=__shfl_xor(b3,32); const int j1=__shfl_xor(i1,32),j2=__shfl_xor(i2,32),j3=__shfl_xor(i3,32);
      INS(p1,j1);INS(p2,j2);INS(p3,j3); }
    #undef INS
    if(b1>-INFINITY)selmask|=1u<<i1; if(b2>-INFINITY)selmask|=1u<<i2; if(b3>-INFINITY)selmask|=1u<<i3;
  }
  #define SELT(t) (((t)>=NT-4)||((selmask>>((t)>>2))&1u))
  float mhat=0.f,l_reg=0.f;f32x16 o[2];o[0]=f32x16{};o[1]=f32x16{};f32x16 negm;
  { const float nv_=SELT(0)?0.f:-INFINITY; _Pragma("unroll") for(int r=0;r<16;++r)negm[r]=nv_; } asm volatile("":"+v"(negm));
  const int qrel=wid*QBLK+r32;
  #define CMASK(P0,P1,t) do{int jb_=(t)-(NT-4); if(jb_>=0)cmask(P0,P1,jb_,qrel,hi);}while(0)
  bool resc=false;
  #define START(P0,P1) do{ const float rm=rowmax(P0,P1); resc=false; \
    { const float dl=max2f(rm,-64.f); mhat=fadd_s(mhat,dl); \
      _Pragma("unroll") for(int r=0;r<16;++r){P0[r]=fsub_s(P0[r],dl);P1[r]=fsub_s(P1[r],dl);} \
      _Pragma("unroll") for(int r=0;r<16;++r)negm[r]=-mhat; asm volatile("":"+v"(negm)); } \
    _Pragma("unroll") for(int r=0;r<16;++r)P0[r]=__builtin_amdgcn_exp2f(P0[r]); }while(0)
  #define RESC() do{ if(resc){ asm volatile("s_waitcnt lgkmcnt(0)":::"memory"); \
      _Pragma("unroll") for(int d_=0;d_<2;++d_) _Pragma("unroll") for(int r=0;r<16;++r)o[d_][r]*=wsf[crow(r,hi)]; } }while(0)
  f32x16 pA0,pA1,pB0,pB1;
  int sl_prev=0,sl_cur=0,sl_next=SLOTB;
  #define ROT() do{sl_prev=sl_cur;sl_cur=sl_next;sl_next=(sl_next==(NSLOT-1)*SLOTB)?0:sl_next+SLOTB;}while(0)
  DMA_K(2,2*SLOTB);
  WAIT_BAR(3);
  qkt(pA0,pA1,Kbase,qr,negm,r32,hi);asm volatile("s_nop 15\n\ts_nop 7":"+v"(pA0),"+v"(pA1));CMASK(pA0,pA1,0);
  START(pA0,pA1);
  _Pragma("unroll") for(int r=0;r<16;++r)pA1[r]=__builtin_amdgcn_exp2f(pA1[r]);
  WAIT_BAR(0);
  DMA_K(3,0);DMA_V(1,SLOTB);
  ROT();
  kload8(kf,kp0+sl_cur);
  WAIT_BAR(2);
  s16x4 vlo[8],vhi[8]; u32x4 pw0,pw1,pw2,pw3;
  #define PKW(P,B) cvtpk_s(P[B],P[B+1])
  #define PAF(k) __builtin_bit_cast(bf16x8,pw##k)
  #define VFR(i) (bf16x8){vlo[i][0],vlo[i][1],vlo[i][2],vlo[i][3],vhi[i][0],vhi[i][1],vhi[i][2],vhi[i][3]}
  #define PIN(x) asm volatile("":"+v"(x))
  #define MX3(a,b,c) __builtin_fmaxf(__builtin_fmaxf((a),(b)),(c))
  #define GAPA(MF,A0,A1,A2,A3,W0,W1,PW) do{ MF; sacc+=A0; sacc+=A1; sacc+=A2; sacc+=A3; PIN(sacc); W0; W1; PIN(PW); SBAR(); }while(0)
  #define EX(v) __builtin_amdgcn_exp2f(v)
  #define GAPB(MF,X,B) do{ MF; X[B]=EX(X[B]); X[B+1]=EX(X[B+1]); X[B+2]=EX(X[B+2]); X[B+3]=EX(X[B+3]); PIN(X); SBAR(); }while(0)
  #define VRD(i) do{ vlo[i]=vtr(vp_+(((i)>>2)*4096+((i)&3)*1024)); vhi[i]=vtr(vp_+(((i)>>2)*4096+((i)&3)*1024+512)); }while(0)
  #define KRD(G,j) do{ if(G){ kload2(kf,kp0+sl_next,j); SBAR(); } }while(0)
  #define STEP(C0,C1,P0,P1,t,GK,GV,GL) do{ SBAR(); \
    { const float nv_=SELT(t)?-mhat:-INFINITY; _Pragma("unroll") for(int r=0;r<16;++r)negm[r]=nv_; asm volatile("":"+v"(negm)); } \
    const lds_cptr vp_=vp0+sl_prev; \
    VRD(0); SBAR(); float sacc=(P0[0]+P0[1]); \
    GAPA(C0=__builtin_amdgcn_mfma_f32_32x32x16_bf16(kf[0],qr[0],negm,0,0,0), P0[2],P0[3],P0[4],P0[5],     pw0[0]=PKW(P0,0), pw0[1]=PKW(P0,2), pw0); \
    VRD(4); SBAR(); GAPA(C1=__builtin_amdgcn_mfma_f32_32x32x16_bf16(kf[1],qr[0],negm,0,0,0), P0[6],P0[7],P0[8],P0[9],     pw0[2]=PKW(P0,4), pw0[3]=PKW(P0,6), pw0); \
    VRD(1); SBAR(); GAPA(C0=__builtin_amdgcn_mfma_f32_32x32x16_bf16(kf[2],qr[1],C0,0,0,0),   P0[10],P0[11],P0[12],P0[13], pw1[0]=PKW(P0,8), pw1[1]=PKW(P0,10), pw1); \
    VRD(5); SBAR(); GAPA(C1=__builtin_amdgcn_mfma_f32_32x32x16_bf16(kf[3],qr[1],C1,0,0,0),   P0[14],P0[15],P1[0],P1[1],   pw1[2]=PKW(P0,12),pw1[3]=PKW(P0,14), pw1); \
    VRD(2); SBAR(); GAPA(C0=__builtin_amdgcn_mfma_f32_32x32x16_bf16(kf[4],qr[2],C0,0,0,0),   P1[2],P1[3],P1[4],P1[5],     pw2[0]=PKW(P1,0), pw2[1]=PKW(P1,2), pw2); \
    VRD(6); SBAR(); GAPA(C1=__builtin_amdgcn_mfma_f32_32x32x16_bf16(kf[5],qr[2],C1,0,0,0),   P1[6],P1[7],P1[8],P1[9],     pw2[2]=PKW(P1,4), pw2[3]=PKW(P1,6), pw2); \
    VRD(3); SBAR(); GAPA(C0=__builtin_amdgcn_mfma_f32_32x32x16_bf16(kf[6],qr[3],C0,0,0,0),   P1[10],P1[11],P1[12],P1[13], pw3[0]=PKW(P1,8), pw3[1]=PKW(P1,10), pw3); \
    VRD(7); SBAR(); GAPA(C1=__builtin_amdgcn_mfma_f32_32x32x16_bf16(kf[7],qr[3],C1,0,0,0),   P1[14],P1[15],0.f,0.f,       pw3[2]=PKW(P1,12),pw3[3]=PKW(P1,14), pw3); \
    l_reg+=sacc; \
    if(GK){DMA_K((t)+3,sl_cur);} if(GV){DMA_V((t)+1,sl_next);} \
    CMASK(C0,C1,t); \
    { float a=MX3(C0[0],C0[1],C1[0]),b=MX3(C0[2],C0[3],C1[1]); a=MX3(a,C1[2],C1[3]); \
      _Pragma("unroll") for(int r=4;r<16;r+=4){a=MX3(a,C0[r],C0[r+1]);b=MX3(b,C0[r+2],C0[r+3]);a=MX3(a,C1[r],C1[r+1]);b=MX3(b,C1[r+2],C1[r+3]);} \
      float rm=__builtin_fmaxf(a,b); { auto rr=__builtin_amdgcn_permlane32_swap(__float_as_uint(rm),__float_as_uint(rm),false,false); rm=__builtin_fmaxf(__uint_as_float(rr[0]),__uint_as_float(rr[1])); } \
      resc=false; \
      if(__builtin_expect(__any(rm>(float)THRL),0)){ const float dl=__builtin_fmaxf(rm,0.f); mhat+=dl; \
        _Pragma("unroll") for(int r=0;r<16;++r){C0[r]-=dl;C1[r]-=dl;} \
        const float f=__builtin_amdgcn_exp2f(-dl); l_reg*=f; if(hi==0)wsf[r32]=f; resc=true; } } \
    SBAR(); \
    GAPB(o[0]=__builtin_amdgcn_mfma_f32_32x32x16_bf16(PAF(0),VFR(0),o[0],0,0,0), C0,0); \
    GAPB(o[1]=__builtin_amdgcn_mfma_f32_32x32x16_bf16(PAF(0),VFR(4),o[1],0,0,0), C0,4); \
    KRD(GL,0); GAPB(o[0]=__builtin_amdgcn_mfma_f32_32x32x16_bf16(PAF(1),VFR(1),o[0],0,0,0), C0,8); \
    KRD(GL,1); GAPB(o[1]=__builtin_amdgcn_mfma_f32_32x32x16_bf16(PAF(1),VFR(5),o[1],0,0,0), C0,12); \
    KRD(GL,2); GAPB(o[0]=__builtin_amdgcn_mfma_f32_32x32x16_bf16(PAF(2),VFR(2),o[0],0,0,0), C1,0); \
    KRD(GL,3); GAPB(o[1]=__builtin_amdgcn_mfma_f32_32x32x16_bf16(PAF(2),VFR(6),o[1],0,0,0), C1,4); \
    GAPB(o[0]=__builtin_amdgcn_mfma_f32_32x32x16_bf16(PAF(3),VFR(3),o[0],0,0,0), C1,8); \
    GAPB(o[1]=__builtin_amdgcn_mfma_f32_32x32x16_bf16(PAF(3),VFR(7),o[1],0,0,0), C1,12); \
    }while(0)
  int t=1;
  #undef CMASK
  #define CMASK(P0,P1,t) do{}while(0)
  for(;t+5<NT;t+=2){
    STEP(pB0,pB1,pA0,pA1,t,true,true,true);     WAIT_BAR(2); RESC(); ROT();
    STEP(pA0,pA1,pB0,pB1,t+1,true,true,true);   WAIT_BAR(2); RESC(); ROT();
  }
  #undef CMASK
  #define CMASK(P0,P1,t) do{int jb_=(t)-(NT-4); if(jb_>=0)cmask(P0,P1,jb_,qrel,hi);}while(0)
  #define ENDW(tt) do{ if((tt)+3<NT){WAIT_BAR(2);} else if((tt)+2<NT){WAIT_BAR(1);} else {WAIT_BAR(0);} }while(0)
  for(;t+1<NT;t+=2){
    STEP(pB0,pB1,pA0,pA1,t,(t+3<NT),(t+1<NT),(t+1<NT));       ENDW(t);   RESC(); ROT();
    STEP(pA0,pA1,pB0,pB1,t+1,(t+4<NT),(t+2<NT),(t+2<NT));     ENDW(t+1); RESC(); ROT();
  }
  STEP(pB0,pB1,pA0,pA1,NT-1,false,false,false); RESC();
  { float sacc=pB0[0]+pB0[1]; _Pragma("unroll") for(int r=2;r<16;++r)sacc+=pB0[r]; _Pragma("unroll") for(int r=0;r<16;++r)sacc+=pB1[r]; l_reg+=sacc;
    pw0=(u32x4){PKW(pB0,0),PKW(pB0,2),PKW(pB0,4),PKW(pB0,6)};pw1=(u32x4){PKW(pB0,8),PKW(pB0,10),PKW(pB0,12),PKW(pB0,14)};pw2=(u32x4){PKW(pB1,0),PKW(pB1,2),PKW(pB1,4),PKW(pB1,6)};pw3=(u32x4){PKW(pB1,8),PKW(pB1,10),PKW(pB1,12),PKW(pB1,14)};
    SBAR(); pv(o,vb0+sl_cur,PAF(0),PAF(1),PAF(2),PAF(3)); }
  #undef PKW
  #undef PAF
  #undef VFR
  #undef PIN
  #undef MX3
  #undef GAPA
  #undef GAPB
  #undef EX
  #undef VRD
  #undef KRD
  #undef STEP
  #undef ENDW
  {auto rr=__builtin_amdgcn_permlane32_swap(__float_as_uint(l_reg),__float_as_uint(l_reg),false,false);l_reg=__uint_as_float(rr[0])+__uint_as_float(rr[1]);}
  if(hi==0)wsf[32+r32]=l_reg;asm volatile("s_waitcnt lgkmcnt(0)":::"memory");
  float rli[16];
  #pragma unroll
  for(int r=0;r<16;++r)rli[r]=__builtin_amdgcn_rcpf(wsf[32+crow(r,hi)]);
  bf16*Ow=O+(rowbase+q0+wid*QBLK)*OPITCH+h*D;
  { bf16*stg=(bf16*)(shm+LDS_OST)+wid*2048;
    #pragma unroll
    for(int r=0;r<16;++r){const int orow=crow(r,hi);
      #pragma unroll
      for(int d0=0;d0<2;++d0)stg[orow*64+d0*32+r32]=__float2bfloat16(o[d0][r]*rli[r]);}
    asm volatile("s_waitcnt lgkmcnt(0)":::"memory");
    #pragma unroll
    for(int i=0;i<4;++i){const int row=i*8+(lane>>3),ch=lane&7; const u32x4 v=*(const u32x4*)(stg+row*64+ch*8); ATTN_STORE16(Ow+(long)row*OPITCH+ch*8,v);} }
  asm volatile("s_waitcnt lgkmcnt(0)\n\ts_barrier":::"memory");
  #undef DMA_K
  #undef DMA_V
  #undef CMASK
  #undef START
  #undef RESC
  #undef ROT
  #undef SELT
}
constexpr int ATTN_LDS_BYTES=LDS_BYTES;
struct AttnTensors { const bf16* Q; const bf16* K; const bf16* V; bf16* O; const float* kmean; };
struct AttnUnit { int bh; int qb; };
struct StaticOrder {
  int vcu,G;
  __device__ __forceinline__ explicit StaticOrder(int grid,int block):vcu((grid%8==0)?(block%8)*(grid/8)+block/8:block),G(grid){}
  __device__ __forceinline__ bool next(int i,AttnUnit&u)const{ const int slot=vcu+(i>>1)*G; if(slot>=256)return false; const int s=slot&15; u.bh=slot>>4; u.qb=(i&1)?31-s:s; return true; }
  __device__ __forceinline__ void a_ready(const AttnUnit&)const{}
  __device__ __forceinline__ void done(const AttnUnit&)const{}
};
template<class Sched,int THRL=8> __device__ __forceinline__ void attn_phase(char*lds,const AttnTensors&T,const Sched&S){
  AttnUnit u;
  for(int i=0;S.next(i,u);++i){ S.a_ready(u); attn_unit<THRL>(u.bh/NHEAD,u.bh%NHEAD,u.qb,T.Q,T.K,T.V,T.O,T.kmean,lds); S.done(u); }
}
#undef SBAR
#undef WAIT_BAR
}

namespace gla {
using bf16x8 = __attribute__((ext_vector_type(8))) short;
using f32x16 = __attribute__((ext_vector_type(16))) float;
using f32x4 = __attribute__((ext_vector_type(4))) float;
using u32x4 = __attribute__((ext_vector_type(4))) unsigned;
using u32x2 = __attribute__((ext_vector_type(2))) unsigned;
typedef float f32x2_t __attribute__((ext_vector_type(2))); typedef __bf16 bf16x2_t __attribute__((ext_vector_type(2)));
#define GLDS __attribute__((address_space(3)))
__device__ __forceinline__ unsigned cvtpk(float lo, float hi) { f32x2_t v = {lo, hi}; bf16x2_t b = __builtin_convertvector(v, bf16x2_t); return __builtin_bit_cast(unsigned, b); }
__device__ __forceinline__ int crow(int r, int hi) { return (r & 3) + 8 * (r >> 2) + 4 * hi; }
__device__ __forceinline__ int swz(int row, int e) { return row * 128 + ((((e >> 3) ^ (row & 7))) << 4) + (e & 7) * 2; }
#define GMFMA(a, b, c) __builtin_amdgcn_mfma_f32_32x32x16_bf16((a), (b), (c), 0, 0, 0)
struct Bufs { const bf16_t *gq, *gk, *gv, *sr; const float* loga; const float* gnorm; float* U; bf16_t* SS; float* DEC; bf16_t* ymix; };

__device__ __forceinline__ void stage_vt(GLDS unsigned char* lds, const bf16_t* gv, int r0, int j) {
    unsigned w[64];
    const unsigned* src = (const unsigned*)(gv + (size_t)r0 * 512) + j;
#pragma unroll
    for (int t = 0; t < 64; ++t) w[t] = src[(size_t)t * 256];
    const int vc = 2 * j, h = vc >> 7, v = vc & 127;
    GLDS unsigned char* vt = lds + 32768 * h + 16384;
#pragma unroll
    for (int c = 0; c < 8; ++c) { u32x4 lo, hi;
#pragma unroll
        for (int p = 0; p < 4; ++p) { const unsigned a = w[8 * c + 2 * p], b = w[8 * c + 2 * p + 1]; lo[p] = (a & 0xffffu) | (b << 16); hi[p] = (a >> 16) | (b & 0xffff0000u); }
        *(GLDS u32x4*)(vt + v * 128 + ((c ^ (v & 7)) << 4)) = lo; *(GLDS u32x4*)(vt + (v + 1) * 128 + ((c ^ ((v + 1) & 7)) << 4)) = hi; }
}

__device__ __forceinline__ void g1_unit(GLDS unsigned char* lds, const Bufs& B, int b, int c, int tid) {
    const int r0 = b * SEQ + c * 64; const int wave = __builtin_amdgcn_readfirstlane(tid >> 6), lane = tid & 63;
    if (tid < 256) { const int col = tid, h = col >> 6, d = col & 63; float G[64];
        const float* lp = B.loga + (size_t)r0 * 256 + col;
#pragma unroll
        for (int t = 0; t < 64; ++t) G[t] = lp[(size_t)t * 256];
#pragma unroll
        for (int t = 1; t < 64; ++t) G[t] += G[t - 1];
        const float gl = G[63];
        B.DEC[(size_t)(b * 128 + c) * 256 + col] = __expf(gl);
        const bf16_t* kp = B.gk + (size_t)r0 * 256 + col; GLDS unsigned char* k2t = lds + 32768 * h;
#pragma unroll
        for (int cc = 0; cc < 8; ++cc) { float kv[8];
#pragma unroll
            for (int e = 0; e < 8; ++e) { const int s = 8 * cc + e; kv[e] = bf2f(kp[(size_t)s * 256]) * __expf(gl - G[s]); }
            u32x4 w; w[0] = cvtpk(kv[0], kv[1]); w[1] = cvtpk(kv[2], kv[3]); w[2] = cvtpk(kv[4], kv[5]); w[3] = cvtpk(kv[6], kv[7]);
            *(GLDS u32x4*)(k2t + d * 128 + ((cc ^ (d & 7)) << 4)) = w; }
    } else stage_vt(lds, B.gv, r0, tid - 256);
    __syncthreads();
    { const int h = wave >> 1, vh = wave & 1, r32 = lane & 31, hi = lane >> 5; GLDS unsigned char* hb = lds + 32768 * h;
      bf16x8 bf[2][4];
#pragma unroll
      for (int dt = 0; dt < 2; ++dt)
#pragma unroll
          for (int k = 0; k < 4; ++k) bf[dt][k] = *(GLDS bf16x8*)(hb + swz(32 * dt + r32, 16 * k + 8 * hi));
      float* up = B.U + ((size_t)((b * 128 + c) * 4 + h)) * 8192;
#pragma unroll
      for (int vi = 0; vi < 2; ++vi) { const int vt = 2 * vh + vi; bf16x8 af[4];
#pragma unroll
          for (int k = 0; k < 4; ++k) af[k] = *(GLDS bf16x8*)(hb + 16384 + swz(32 * vt + r32, 16 * k + 8 * hi));
#pragma unroll
          for (int dt = 0; dt < 2; ++dt) { f32x16 acc = f32x16{};
#pragma unroll
              for (int k = 0; k < 4; ++k) acc = GMFMA(af[k], bf[dt][k], acc);
#pragma unroll
              for (int r = 0; r < 16; ++r) up[(size_t)(32 * vt + crow(r, hi)) * 64 + 32 * dt + r32] = acc[r]; } }
    }
    __syncthreads();
}

__device__ __forceinline__ void g2_scan(const Bufs& B, int gid) {
    const int d = gid & 63, v = (gid >> 6) & 127, h = (gid >> 13) & 3, b = gid >> 15;
    const float* up = B.U + ((size_t)(b * 128) * 4 + h) * 8192 + v * 64 + d; bf16_t* sp = B.SS + ((size_t)(b * 128) * 4 + h) * 8192 + v * 64 + d;
    const float* dp = B.DEC + (size_t)(b * 128) * 256 + h * 64 + d;
    float S = 0.f;
#pragma unroll 8
    for (int c = 0; c < 128; ++c) { const float u = up[(size_t)c * 4 * 8192], dc = dp[(size_t)c * 256]; sp[(size_t)c * 4 * 8192] = (bf16_t)f2bf(S); S = dc * S + u; }
}

__device__ __forceinline__ void g3_unit(GLDS unsigned char* lds, const Bufs& B, int b, int c, int tid) {
    const int r0 = b * SEQ + c * 64; const int wave = __builtin_amdgcn_readfirstlane(tid >> 6), lane = tid & 63;
    if (tid < 256) { const int col = tid, h = col >> 6, d = col & 63; float G[64];
        const float* lp = B.loga + (size_t)r0 * 256 + col;
#pragma unroll
        for (int t = 0; t < 64; ++t) G[t] = lp[(size_t)t * 256];
#pragma unroll
        for (int t = 1; t < 64; ++t) G[t] += G[t - 1];
        const bf16_t* qp = B.gq + (size_t)r0 * 256 + col; const bf16_t* kp = B.gk + (size_t)r0 * 256 + col; GLDS unsigned char* hb = lds + 32768 * h;
#pragma unroll
        for (int t = 0; t < 64; ++t) { const float e = __expf(G[t]); const float qd = bf2f(qp[(size_t)t * 256]) * e, kd = bf2f(kp[(size_t)t * 256]) * __builtin_amdgcn_rcpf(e);
            *(GLDS bf16_t*)(hb + swz(t, d)) = (bf16_t)(cvtpk(qd, qd) & 0xffffu); *(GLDS bf16_t*)(hb + 8192 + swz(t, d)) = (bf16_t)(cvtpk(kd, kd) & 0xffffu); }
    } else stage_vt(lds, B.gv, r0, tid - 256);
    __syncthreads();
    { const int h = wave >> 1, tt = wave & 1, r32 = lane & 31, hi = lane >> 5; GLDS unsigned char* hb = lds + 32768 * h;
      bf16x8 qf[4];
#pragma unroll
      for (int k = 0; k < 4; ++k) qf[k] = *(GLDS bf16x8*)(hb + swz(32 * tt + r32, 16 * k + 8 * hi));
      f32x16 o[4];
#pragma unroll
      for (int vt = 0; vt < 4; ++vt) o[vt] = f32x16{};
      const bf16_t* ssp = B.SS + ((size_t)((b * 128 + c) * 4 + h)) * 8192;
#pragma unroll
      for (int vt = 0; vt < 4; ++vt) { bf16x8 sf[4];
#pragma unroll
          for (int k = 0; k < 4; ++k) sf[k] = *(const bf16x8*)(ssp + (size_t)(32 * vt + r32) * 64 + 16 * k + 8 * hi);
#pragma unroll
          for (int k = 0; k < 4; ++k) o[vt] = GMFMA(sf[k], qf[k], o[vt]); }
#pragma unroll
      for (int ss = 0; ss < 2; ++ss) if (ss <= tt) {
          f32x16 x = f32x16{};
#pragma unroll
          for (int k = 0; k < 4; ++k) { const bf16x8 kf = *(GLDS bf16x8*)(hb + 8192 + swz(32 * ss + r32, 16 * k + 8 * hi)); x = GMFMA(kf, qf[k], x); }
          if (ss == tt) {
#pragma unroll
              for (int r = 0; r < 16; ++r) x[r] = (crow(r, hi) > r32) ? 0.f : x[r]; }
#pragma unroll
          for (int sp = 0; sp < 2; ++sp) { u32x4 xw; xw[0] = cvtpk(x[8 * sp], x[8 * sp + 1]); xw[1] = cvtpk(x[8 * sp + 2], x[8 * sp + 3]); xw[2] = cvtpk(x[8 * sp + 4], x[8 * sp + 5]); xw[3] = cvtpk(x[8 * sp + 6], x[8 * sp + 7]);
              const bf16x8 xs = __builtin_bit_cast(bf16x8, xw);
              const int s1 = 32 * ss + 16 * sp + 4 * hi, s2 = s1 + 8;
#pragma unroll
              for (int vt = 0; vt < 4; ++vt) { const int row = 32 * vt + r32; const u32x2 a0 = *(GLDS u32x2*)(hb + 16384 + swz(row, s1)), a1 = *(GLDS u32x2*)(hb + 16384 + swz(row, s2));
                  u32x4 aw; aw[0] = a0[0]; aw[1] = a0[1]; aw[2] = a1[0]; aw[3] = a1[1];
                  o[vt] = GMFMA(__builtin_bit_cast(bf16x8, aw), xs, o[vt]); } }
      }
      float ssq = 0.f;
#pragma unroll
      for (int vt = 0; vt < 4; ++vt)
#pragma unroll
          for (int r = 0; r < 16; ++r) ssq += o[vt][r] * o[vt][r];
      ssq += __shfl_xor(ssq, 32);
      const float rstd = __builtin_amdgcn_rsqf(ssq * (1.0f / 128.0f) + EPS);
      const int row = r0 + 32 * tt + r32;
#pragma unroll
      for (int vt = 0; vt < 4; ++vt)
#pragma unroll
          for (int g4 = 0; g4 < 4; ++g4) { const int v0 = 32 * vt + 8 * g4 + 4 * hi;
              const f32x4 gg = *(const f32x4*)(B.gnorm + 128 * h + v0); const u32x2 sw = *(const u32x2*)(B.sr + (size_t)row * 512 + 128 * h + v0);
              const float y0 = o[vt][4 * g4] * rstd * gg[0] * __uint_as_float(sw[0] << 16), y1 = o[vt][4 * g4 + 1] * rstd * gg[1] * __uint_as_float(sw[0] & 0xffff0000u);
              const float y2 = o[vt][4 * g4 + 2] * rstd * gg[2] * __uint_as_float(sw[1] << 16), y3 = o[vt][4 * g4 + 3] * rstd * gg[3] * __uint_as_float(sw[1] & 0xffff0000u);
              u32x2 yw; yw[0] = cvtpk(y0, y1); yw[1] = cvtpk(y2, y3);
              *(u32x2*)(B.ymix + (size_t)row * 1024 + 512 + 128 * h + v0) = yw; }
    }
    __syncthreads();
}
#undef GLDS
#undef GMFMA
}

constexpr int NWAVES = 8;
constexpr size_t MiB = 1u << 20;
constexpr size_t WS_CTL = 0, CTL_ZERO_BYTES = 1 * MiB;
constexpr size_t WS_WIN = 2 * MiB, WS_WOUT = 9 * MiB, WS_WUP = 11 * MiB, WS_WDOWN = 22 * MiB;
constexpr size_t WS_ROPE = 28 * MiB, WS_KMEAN = 30 * MiB, WS_SSQA = 31 * MiB, WS_SSQB = 32 * MiB;
constexpr size_t WS_XN = 34 * MiB + 65536;
constexpr size_t WS_Q = 68 * MiB, WS_K = 84 * MiB, WS_V = 100 * MiB, WS_GQ = 116 * MiB, WS_GK = 124 * MiB, WS_GV = 132 * MiB, WS_SR = 148 * MiB, WS_LOGA = 164 * MiB, WS_ADEC = 180 * MiB;
constexpr size_t WS_YMIX = 196 * MiB;
constexpr size_t WS_ACT = 68 * MiB;
constexpr size_t WS_END = 256 * MiB;
constexpr int CW_BAR = 4096;

constexpr int RING_OFF = 0, RING_BYTES = 131072;
constexpr int LDSCTL_OFF = RING_BYTES, MISC_OFF = LDSCTL_OFF + 320;
constexpr int LDS_BYTES = 147456;

#define GAS __attribute__((address_space(1)))
#define LAS __attribute__((address_space(3)))
typedef unsigned v4u __attribute__((ext_vector_type(4)));
typedef float f32x4 __attribute__((ext_vector_type(4)));
typedef GAS unsigned gu32;
#define RLX_AGENT __ATOMIC_RELAXED, __HIP_MEMORY_SCOPE_AGENT
#define LDS_WAIT() asm volatile("s_waitcnt lgkmcnt(0)" ::: "memory")
#define VM_WAIT() asm volatile("s_waitcnt vmcnt(0)" ::: "memory")
__device__ __forceinline__ unsigned pk2(float lo, float hi) { return f2bf(lo) | (f2bf(hi) << 16); }
#define XB_TMO      128
#define XB_XCNT(j)  (256  + 64 * (j))
#define XB_XSUB(j)  (1280 + 64 * (j))
#define XB_XGEN(j)  (2304 + 64 * (j))
#define XB_TOP      3328
#define XB_TOPGEN   3392
#define XCD_BAR_WORDS 3456
#define XB_SPIN_CAP (1u << 18)

__device__ __forceinline__ unsigned xb_ld(unsigned* p)              { return __hip_atomic_load(p, __ATOMIC_RELAXED, __HIP_MEMORY_SCOPE_AGENT); }
__device__ __forceinline__ unsigned xb_add(unsigned* p, unsigned v) { return __hip_atomic_fetch_add(p, v, __ATOMIC_RELAXED, __HIP_MEMORY_SCOPE_AGENT); }
__device__ __forceinline__ unsigned xb_xcc_id() { return (unsigned)__builtin_amdgcn_s_getreg((3 << 11) | 20) & 0xFu; }
#define XB_SPIN(cond, bar) do { unsigned _sp = 0; while (cond) { __builtin_amdgcn_s_sleep(1); \
    if ((++_sp & 255u) == 0u) { if (xb_ld(&(bar)[XB_TMO])) break; if (_sp > XB_SPIN_CAP) { atomicAdd(&(bar)[XB_TMO], 1u); break; } } } } while (0)

struct XcdBarrier {
    unsigned* bar; unsigned x;
    volatile LAS unsigned* st;
};

__device__ __forceinline__ XcdBarrier xcd_barrier_post(unsigned* bar, volatile LAS unsigned* st) {
    XcdBarrier b; b.bar = bar; b.x = xb_xcc_id(); b.st = st;
    if (threadIdx.x == 0) (void)xb_add(&bar[XB_XCNT(b.x)], 1u);
    return b;
}
__device__ __forceinline__ void xcd_barrier_complete(unsigned* bar, unsigned x, unsigned& nloc, unsigned& nx) {
    const unsigned G = gridDim.x * gridDim.y * gridDim.z;
    unsigned sum, cnt, mine, sp = 0u;
    for (;;) {
        sum = 0u; cnt = 0u; mine = 0u;
#pragma unroll
        for (unsigned j = 0; j < 16; ++j) { const unsigned c = xb_ld(&bar[XB_XCNT(j)]); sum += c; cnt += (c > 0u) ? 1u : 0u; mine = (j == x) ? c : mine; }
        if (sum == G) break;
        __builtin_amdgcn_s_sleep(1);
        if ((++sp & 255u) == 0u) { if (xb_ld(&bar[XB_TMO])) break; if (sp > XB_SPIN_CAP) { atomicAdd(&bar[XB_TMO], 1u); break; } }
    }
    nloc = mine > 0u ? mine : 1u; nx = cnt > 0u ? cnt : 1u;
}

__device__ __forceinline__ void xcd_barrier(const XcdBarrier& b) {
    asm volatile("s_waitcnt vmcnt(0)" ::: "memory");
    __syncthreads();
    if (threadIdx.x == 0) {
        unsigned* bar = b.bar;
        __builtin_amdgcn_s_waitcnt(0);
        unsigned nloc = b.st[0], nx = b.st[1];
        if (nloc == 0u) { xcd_barrier_complete(bar, b.x, nloc, nx); b.st[0] = nloc; b.st[1] = nx; }
        const unsigned old = xb_add(&bar[XB_XSUB(b.x)], 1u);
        const unsigned gen = old / nloc;
        if (old + 1u == (gen + 1u) * nloc) {
            __builtin_amdgcn_fence(__ATOMIC_RELEASE, "agent");
            asm volatile("s_waitcnt vmcnt(0)" ::: "memory");
            const unsigned og = xb_add(&bar[XB_TOP], 1u);
            const unsigned tg = og / nx;
            if (og + 1u == (tg + 1u) * nx) xb_add(&bar[XB_TOPGEN], 1u);
            else XB_SPIN(xb_ld(&bar[XB_TOPGEN]) == tg, bar);
            __builtin_amdgcn_fence(__ATOMIC_ACQUIRE, "agent");
            xb_add(&bar[XB_XGEN(b.x)], 1u);
            asm volatile("s_waitcnt vmcnt(0)" ::: "memory");
        } else {
            XB_SPIN(xb_ld(&bar[XB_XGEN(b.x)]) == gen, bar);
            __builtin_amdgcn_fence(__ATOMIC_ACQUIRE, "agent");
            asm volatile("s_waitcnt vmcnt(0)" ::: "memory");
        }
    }
    __syncthreads();
}

struct Frame {
    LAS unsigned char* lds; volatile LAS unsigned* MISC; gu32* ctl;
    int tid, lane, wave, vcu, G;
};
template <int CMAP> __device__ __forceinline__ int col_map(int n) {
    if (CMAP == 1) { return (n < 1024) ? ((n & ~63) + ((n & 1) << 5) + ((n & 63) >> 1)) : n; }
    if (CMAP == 2) { const int pn = n >> 8, jj = n & 255; return (jj < 128) ? (pn * 128 + jj) : (DFF + pn * 128 + (jj - 128)); }
    return n;
}
template <int CMAP> __device__ __forceinline__ void p0_transpose_item(const float* W, int K, int ldw, int Nout, bf16_t* WT, LAS float* scr, int item, int lane) {
    const int nblk = Nout / 32, kb = item / nblk, nb = item % nblk, k0 = 64 * kb, n0 = 32 * nb;
    const int sc = col_map<CMAP>(n0 + (lane & 31));
#pragma unroll 8
    for (int i = 0; i < 32; ++i) { const int kk = 2 * i + (lane >> 5); scr[kk * 33 + (lane & 31)] = W[(size_t)(k0 + kk) * ldw + sc]; }
    LDS_WAIT(); asm volatile("" ::: "memory");
    const int c = lane & 7;
#pragma unroll
    for (int j = 0; j < 4; ++j) { const int n = (lane >> 3) + 8 * j; const LAS float* s = scr + (8 * c) * 33 + n;
        v4u o; o.x = pk2(s[0 * 33], s[1 * 33]); o.y = pk2(s[2 * 33], s[3 * 33]); o.z = pk2(s[4 * 33], s[5 * 33]); o.w = pk2(s[6 * 33], s[7 * 33]);
        *(GAS v4u*)(WT + (size_t)(n0 + n) * K + k0 + 8 * c) = o; }
    LDS_WAIT(); asm volatile("" ::: "memory");
}

struct Args { const float* in[13]; float* out; unsigned char* ws; int ph_lo, ph_hi, li, pad; };

__device__ __forceinline__ void p0_prologue(Frame& F, const Args& a) {
    unsigned char* ws = a.ws;
    LAS float* scr = (LAS float*)(F.lds + RING_OFF + F.wave * 16384);
    const int gw = F.vcu * NWAVES + F.wave, NGW = F.G * NWAVES;
    const float* w_in = a.in[2]; const float* w_gate_up = a.in[3]; const float* w_out = a.in[6]; const float* w_up = a.in[8]; const float* w_down = a.in[11];
    bf16_t* WIN = (bf16_t*)(ws + WS_WIN); bf16_t* WOUT = (bf16_t*)(ws + WS_WOUT); bf16_t* WUP = (bf16_t*)(ws + WS_WUP); bf16_t* WDOWN = (bf16_t*)(ws + WS_WDOWN);
    constexpr int I_IN = (DM / 64) * (3072 / 32), I_OUT = (DM / 64) * (DM / 32), I_UP = (DM / 64) * (NUP / 32), I_DOWN = (DFF / 64) * (DM / 32);
    constexpr int NITEMS = I_IN + I_OUT + I_UP + I_DOWN;
    for (int it = gw; it < NITEMS; it += NGW) {
        int r = it;
        if (r < I_IN) { p0_transpose_item<1>(w_in, DM, NIN, 3072, WIN, scr, r, F.lane); continue; } r -= I_IN;
        if (r < I_OUT) { p0_transpose_item<0>(w_out, DM, DM, DM, WOUT, scr, r, F.lane); continue; } r -= I_OUT;
        if (r < I_UP) { p0_transpose_item<2>(w_up, DM, NUP, NUP, WUP, scr, r, F.lane); continue; } r -= I_UP;
        p0_transpose_item<0>(w_down, DFF, DM, DM, WDOWN, scr, r, F.lane);
    }
    const int gt = gw * 64 + F.lane, NGT = NGW * 64;
    for (int idx = gt; idx < 256 * 128; idx += NGT) { const int c = idx & 255, k0 = (idx >> 8) * 8; float wg[16];
#pragma unroll
        for (int r = 0; r < 16; ++r) wg[r] = w_gate_up[r * 256 + c];
        float o[8];
#pragma unroll
        for (int e = 0; e < 8; ++e) { const f32x4* wp = (const f32x4*)(w_in + (size_t)(k0 + e) * NIN + 3072); float s = 0.f;
#pragma unroll
            for (int r4 = 0; r4 < 4; ++r4) { const f32x4 w4 = wp[r4]; s += w4[0] * wg[4 * r4] + w4[1] * wg[4 * r4 + 1] + w4[2] * wg[4 * r4 + 2] + w4[3] * wg[4 * r4 + 3]; }
            o[e] = s; }
        v4u w; w.x = pk2(o[0], o[1]); w.y = pk2(o[2], o[3]); w.z = pk2(o[4], o[5]); w.w = pk2(o[6], o[7]);
        *(GAS v4u*)(WIN + (size_t)(3072 + c) * DM + k0) = w; }
    { float2* tab = (float2*)(ws + WS_ROPE);
      for (int idx = gt; idx < SEQ * 32; idx += NGT) { const int pos = idx >> 5, i = idx & 31; const double rev = (double)pos * INV_FREQ[i] * 0.15915494309189535; const float f = (float)(rev - __builtin_rint(rev));
          tab[idx] = make_float2(__builtin_amdgcn_cosf(f), __builtin_amdgcn_sinf(f)); } }
    { float* km = (float*)(ws + WS_KMEAN); for (int idx = gt; idx < NB * 32 * 512; idx += NGT) km[idx] = 0.f; }
    { const float* x = a.in[0]; const float* g = a.in[1]; bf16_t* XN = (bf16_t*)(ws + WS_XN);
      for (int m = gw; m < M; m += NGW) { const GAS f32x4* xr = (const GAS f32x4*)(x + (size_t)m * DM) + F.lane; f32x4 v[4]; float s = 0.f;
#pragma unroll
          for (int j = 0; j < 4; ++j) { v[j] = xr[64 * j]; s += (v[j].x * v[j].x + v[j].y * v[j].y) + (v[j].z * v[j].z + v[j].w * v[j].w); }
          const float rstd = 1.f / sqrtf(wave_sum(s) * (1.f / DM) + EPS);
          GAS unsigned long long* o8 = (GAS unsigned long long*)(XN + (size_t)m * DM) + F.lane;
#pragma unroll
          for (int j = 0; j < 4; ++j) { const f32x4 gg = ((const GAS f32x4*)g)[64 * j + F.lane];
              o8[64 * j] = (unsigned long long)pk2(v[j].x * rstd * gg.x, v[j].y * rstd * gg.y) | ((unsigned long long)pk2(v[j].z * rstd * gg.z, v[j].w * rstd * gg.w) << 32); } } }
}
__device__ __forceinline__ void p_final(Frame& F, const Args& a) {
    const int gw = F.vcu * NWAVES + F.wave, NGW = F.G * NWAVES; const float* g = a.in[12]; const float* ssq = (const float*)(a.ws + WS_SSQB);
    const int lane = (int)__builtin_amdgcn_mbcnt_hi(~0u, __builtin_amdgcn_mbcnt_lo(~0u, 0u));
    for (int m = gw; m < M; m += NGW) { GAS f32x4* yr = (GAS f32x4*)(a.out + (size_t)m * DM) + lane;
        const float p = (lane < 16) ? ssq[(size_t)m * 16 + lane] : 0.f; const float rstd = 1.f / sqrtf(wave_sum(p) * (1.f / DM) + EPS);
#pragma unroll
        for (int j = 0; j < 4; ++j) { const f32x4 v = yr[64 * j]; const f32x4 gg = ((const GAS f32x4*)g)[64 * j + lane]; yr[64 * j] = v * rstd * gg; } }
}

__global__ void __launch_bounds__(NWAVES * 64, 2) skel_fwd(Args args) {
    extern __shared__ __attribute__((aligned(16))) unsigned char lds[];
    Frame F;
    F.lds = (LAS unsigned char*)lds; F.MISC = (volatile LAS unsigned*)(F.lds + MISC_OFF);
    F.tid = threadIdx.x; F.lane = F.tid & 63; F.wave = __builtin_amdgcn_readfirstlane(F.tid >> 6);
    F.G = gridDim.x; { const int bx = blockIdx.x; F.vcu = (F.G % 8 == 0) ? (bx % 8) * (F.G / 8) + bx / 8 : bx; }
    unsigned char* ws = args.ws; F.ctl = (gu32*)(ws + WS_CTL);
    for (int u = F.tid; u < (LDS_BYTES - LDSCTL_OFF) / 4; u += NWAVES * 64) ((LAS unsigned*)(F.lds + LDSCTL_OFF))[u] = 0u;
    __syncthreads();
    XcdBarrier bar = xcd_barrier_post((unsigned*)(F.ctl + CW_BAR) + args.li * XCD_BAR_WORDS, F.MISC + 8);
    const int lo = args.ph_lo, hi = args.ph_hi;
#define IN(k) (lo <= (k) && (k) < hi)
#define BOTH(k) (IN(k) && IN((k) + 1))
#define GRID_BAR() xcd_barrier(bar)
    bf16_t* XN = (bf16_t*)(ws + WS_XN);
    if (IN(0)) { p0_prologue(F, args); if (BOTH(0)) GRID_BAR(); }
    if (IN(1)) {
        pg8::Gemm g{XN, (const bf16_t*)(ws + WS_WIN), M, NINP, DM}; pg8::StaticOrder S; S.init(M / 256, NINP / 256, F.G, (int)blockIdx.x);
        pg8::EpiInProj E{(bf16_t*)(ws + WS_Q), (bf16_t*)(ws + WS_K), (bf16_t*)(ws + WS_V), (bf16_t*)(ws + WS_GQ), (bf16_t*)(ws + WS_GK), (bf16_t*)(ws + WS_GV), (bf16_t*)(ws + WS_SR),
                         (float*)(ws + WS_LOGA), (float*)(ws + WS_KMEAN), (const float*)(ws + WS_ROPE), args.in[4]};
        pg8::gemm_phase<pg8::EpiInProj, pg8::StaticOrder, pg8::AMapStd, true, true>(F.lds + RING_OFF, g, S, E);
        if (BOTH(1)) GRID_BAR();
    }
    if (IN(2)) {
        IF1 f; f.q = (bf16_t*)(ws + WS_Q); f.k = (bf16_t*)(ws + WS_K); f.v = (bf16_t*)(ws + WS_V); f.gq = (bf16_t*)(ws + WS_GQ); f.gk = (bf16_t*)(ws + WS_GK); f.gv = (bf16_t*)(ws + WS_GV);
        f.sr = (bf16_t*)(ws + WS_SR); f.loga = (float*)(ws + WS_LOGA); f.adec = (float*)(ws + WS_ADEC); f.kmean = (float*)(ws + WS_KMEAN); f.rope = (const float2*)(ws + WS_ROPE);
        bf16_t* ymix = (bf16_t*)(ws + WS_YMIX); float* oraw = args.out;
        const int gw = F.vcu * NWAVES + F.wave, NGW = F.G * NWAVES;
        const gla::Bufs GB{f.gq, f.gk, f.gv, f.sr, f.loga, args.in[5], args.out, (bf16_t*)(args.out + (size_t)8 * 1024 * 1024), (float*)(ws + WS_ADEC), ymix};
        for (int u = F.vcu; u < 256; u += F.G) gla::g1_unit(F.lds + RING_OFF, GB, u >> 7, u & 127, F.tid);
        GRID_BAR();
        if (F.tid < 256) for (int g = (int)blockIdx.x * 256 + F.tid; g < 65536; g += F.G * 256) gla::g2_scan(GB, g);
        GRID_BAR();
        for (int u = F.vcu; u < 256; u += F.G) gla::g3_unit(F.lds + RING_OFF, GB, u >> 7, u & 127, F.tid);
        { const attn_body::AttnTensors AT{(const attn_body::bf16*)f.q, (const attn_body::bf16*)f.k, (const attn_body::bf16*)f.v, (attn_body::bf16*)ymix, f.kmean};
          const attn_body::StaticOrder S((int)F.G, (int)blockIdx.x);
          attn_body::attn_phase<attn_body::StaticOrder>((char*)lds + RING_OFF, AT, S); }
        if (BOTH(2)) GRID_BAR();
    }
    if (IN(3)) {
        pg8::Gemm g{(const bf16_t*)(ws + WS_YMIX), (const bf16_t*)(ws + WS_WOUT), M, DM, DM}; pg8::StaticOrder S; S.init(M / 256, DM / 256, F.G, (int)blockIdx.x);
        pg8::EpiOutProj E{args.in[0], args.out, XN, args.in[7], (float*)(ws + WS_SSQA)};
        pg8::gemm_phase<pg8::EpiOutProj, pg8::StaticOrder, pg8::AMapStd, true, true>(F.lds + RING_OFF, g, S, E);
        if (BOTH(3)) GRID_BAR();
    }
    if (IN(4)) {
        pg8::Gemm g{XN, (const bf16_t*)(ws + WS_WUP), M, NUP, DM}; pg8::StaticOrder S; S.init(66, NUP / 256, F.G, (int)blockIdx.x);
        pg8::EpiUp E{(const float*)(ws + WS_SSQA), args.in[9], args.in[10], (bf16_t*)(ws + WS_ACT)};
        pg8::gemm_phase<pg8::EpiUp, pg8::StaticOrder, pg8::AMapConv, true, true>(F.lds + RING_OFF, g, S, E);
        if (BOTH(4)) GRID_BAR();
    }
    if (IN(5)) {
        pg8::Gemm g{(const bf16_t*)(ws + WS_ACT), (const bf16_t*)(ws + WS_WDOWN), M, DM, DFF}; pg8::StaticOrder S; S.init(M / 256, DM / 256, F.G, (int)blockIdx.x);
        pg8::EpiDown E{args.out, (float*)(ws + WS_SSQB)};
        pg8::gemm_phase<pg8::EpiDown, pg8::StaticOrder, pg8::AMapStd, true, true>(F.lds + RING_OFF, g, S, E);
        if (BOTH(5)) GRID_BAR();
    }
    if (IN(6)) { p_final(F, args); }
#undef IN
#undef BOTH
#undef GRID_BAR
}


extern "C" void kernel_launch(void* const* d_in, const int* in_sizes, int n_in, void* d_out, int out_size, void* d_ws, size_t ws_size, hipStream_t stream) {
    static int grid = 0;
    if (grid == 0) {
        if (n_in != 13 || in_sizes[0] != M * DM || out_size != M * DM || ws_size < WS_END) { fprintf(stderr, "kernel_launch: unexpected shapes / workspace (%d inputs, ws %zu)\n", n_in, ws_size); grid = -1; return; }
        int dev = 0, cus = 0, per_cu = 0;
        if (hipGetDevice(&dev) != hipSuccess || hipDeviceGetAttribute(&cus, hipDeviceAttributeMultiprocessorCount, dev) != hipSuccess) { grid = -1; return; }
        if (hipFuncSetAttribute((const void*)skel_fwd, hipFuncAttributeMaxDynamicSharedMemorySize, LDS_BYTES) != hipSuccess) { fprintf(stderr, "kernel_launch: hipFuncSetAttribute failed\n"); grid = -1; return; }
        if (hipOccupancyMaxActiveBlocksPerMultiprocessor(&per_cu, (const void*)skel_fwd, NWAVES * 64, LDS_BYTES) != hipSuccess || per_cu < 1) { fprintf(stderr, "kernel_launch: occupancy query says %d\n", per_cu); }
        (void)hipGetLastError();
        grid = cus;
    }
    if (grid < 0) return;
    unsigned char* ws = (unsigned char*)d_ws;
    (void)hipMemsetAsync(ws + WS_CTL, 0, CTL_ZERO_BYTES, stream);
    Args a{};
    for (int i = 0; i < 13; ++i) a.in[i] = (const float*)d_in[i];
    a.out = (float*)d_out; a.ws = ws;
    a.ph_lo = 0; a.ph_hi = 7; a.li = 0;
    hipLaunchKernelGGL(skel_fwd, dim3(grid), dim3(NWAVES * 64), LDS_BYTES, stream, a);
}
```
